# Optimizing an MI355X kernel written in HIP

```python
import math
import jax, jax.numpy as jnp
from jax import lax
import numpy as np

D_MODEL = 2048
BATCH = 2
SEQ = 16384
DEPTH = 2

N_MIXERS = 2
N_LRU_LAYERS = (DEPTH + 1) // 2
N_ATTN_LAYERS = DEPTH // 2
PLE_DIM = 256
NORM_EPS = 1e-6
D_RNN = D_MODEL
N_LRU_BLOCKS = 8
LRU_BLOCK = D_RNN // N_LRU_BLOCKS
CONV_WIDTH = 4
LRU_C = 8.0
DILATION_PAIRS = ((128, 1), (512, 4), (2048, 16))
N_DIL_GROUPS = len(DILATION_PAIRS)
N_HEADS = 8
HEAD_DIM = 128
ATTN_BLOCK = 128
ROPE_THETA = 10000.0
NEG_INF = -1e30
N_GROUPS = 8
EXPERTS_PER_GROUP = 8
N_EXPERTS = N_GROUPS * EXPERTS_PER_GROUP
TOP_K = 2
D_EXPERT = D_MODEL // 4
MOE_BLOCK = 128

kernel_name = "hybrid_rglru_dilated_attn_hmoe"


def rms_norm(x, gain):
    xf = x.astype(jnp.float32)
    y = xf * lax.rsqrt(jnp.mean(xf * xf, axis=-1, keepdims=True) + NORM_EPS)
    return (y * gain.astype(jnp.float32)).astype(x.dtype)


def rope_tables(positions):
    inv = ROPE_THETA ** (-jnp.arange(0, HEAD_DIM, 2, dtype=jnp.float32) / HEAD_DIM)
    ang = positions.astype(jnp.float32)[..., None] * inv
    return jnp.cos(ang), jnp.sin(ang)


def apply_rope(t, cos, sin):
    tf = t.astype(jnp.float32)
    t1, t2 = jnp.split(tf, 2, axis=-1)
    c, s = cos[:, :, None, :], sin[:, :, None, :]
    return jnp.concatenate([t1 * c - t2 * s, t2 * c + t1 * s], axis=-1).astype(t.dtype)


def causal_depthwise_conv(x, w, b):
    y = lax.conv_general_dilated(
        x, w[:, None, :].astype(x.dtype), window_strides=(1,),
        padding=[(CONV_WIDTH - 1, 0)], dimension_numbers=('NWC', 'WIO', 'NWC'),
        feature_group_count=x.shape[-1])
    return y + b.astype(x.dtype)


def rglru_mixer(hn, w_in, conv_w, conv_b, w_rg, b_rg, w_ig, b_ig, lam, w_out):
    B, S, _ = hn.shape
    proj = hn @ w_in
    gate_branch, xr = proj[..., :D_RNN], proj[..., D_RNN:]
    xr = causal_depthwise_conv(xr, conv_w, conv_b)
    xb = xr.reshape(B, S, N_LRU_BLOCKS, LRU_BLOCK)
    r = jax.nn.sigmoid((jnp.einsum('bsnc,ncd->bsnd', xb, w_rg) + b_rg).astype(jnp.float32))
    i = jax.nn.sigmoid((jnp.einsum('bsnc,ncd->bsnd', xb, w_ig) + b_ig).astype(jnp.float32))
    r = r.reshape(B, S, D_RNN)
    i = i.reshape(B, S, D_RNN)
    log_a = LRU_C * r * jax.nn.log_sigmoid(lam.astype(jnp.float32))
    a = jnp.exp(log_a)
    u = jnp.sqrt(-jnp.expm1(2.0 * log_a)) * (i * xr.astype(jnp.float32))

    def combine(left, right):
        a1, b1 = left
        a2, b2 = right
        return a1 * a2, a2 * b1 + b2

    _, h = lax.associative_scan(combine, (a, u), axis=1)
    y = jax.nn.gelu(gate_branch, approximate=True) * h.astype(hn.dtype)
    return y @ w_out


def dilated_window_attention(q, k, v, window, dilation):
    B, S, H, HD = q.shape
    span = dilation * ATTN_BLOCK
    s_pad = -(-S // span) * span
    L = s_pad // dilation
    nb = L // ATTN_BLOCK
    w_sub = window // dilation

    def to_sub(t):
        t = jnp.pad(t, ((0, 0), (0, s_pad - S), (0, 0), (0, 0)))
        t = t.reshape(B, L, dilation, H, HD).transpose(0, 2, 1, 3, 4)
        return t.reshape(B * dilation, nb, ATTN_BLOCK, H, HD)

    qs, ks, vs = to_sub(q), to_sub(k), to_sub(v)

    def with_prev(t):
        prev = jnp.concatenate([jnp.zeros_like(t[:, :1]), t[:, :-1]], axis=1)
        return jnp.concatenate([prev, t], axis=2)

    k2, v2 = with_prev(ks), with_prev(vs)
    scores = jnp.einsum('bnqhd,bnkhd->bnhqk', qs, k2).astype(jnp.float32) * (HD ** -0.5)
    qpos = jnp.arange(ATTN_BLOCK) + ATTN_BLOCK
    kpos = jnp.arange(2 * ATTN_BLOCK)
    rel = qpos[:, None] - kpos[None, :]
    key_sub = jnp.arange(nb)[:, None] * ATTN_BLOCK - ATTN_BLOCK + kpos[None, :]
    valid = ((rel >= 0) & (rel <= w_sub))[None] & (key_sub >= 0)[:, None, :]
    scores = jnp.where(valid[None, :, None], scores, NEG_INF)
    m = jnp.max(scores, axis=-1, keepdims=True)
    pr = jnp.exp(scores - m)
    den = jnp.sum(pr, axis=-1)
    o = jnp.einsum('bnhqk,bnkhd->bnqhd', pr, v2.astype(jnp.float32))
    o = o / jnp.transpose(den, (0, 1, 3, 2))[..., None]
    lse = jnp.transpose(m[..., 0] + jnp.log(den), (0, 1, 3, 2))
    o = o.reshape(B, dilation, L, H, HD).transpose(0, 2, 1, 3, 4).reshape(B, s_pad, H, HD)[:, :S]
    lse = lse.reshape(B, dilation, L, H).transpose(0, 2, 1, 3).reshape(B, s_pad, H)[:, :S]
    return o, lse


def dilated_attention_mixer(hn, cos, sin, w_qkv, q_gain, k_gain, w_o):
    B, S, _ = hn.shape
    qkv = (hn @ w_qkv).reshape(B, S, N_DIL_GROUPS, 3, N_HEADS, HEAD_DIM)
    outs, lses = [], []
    for g, (window, dilation) in enumerate(DILATION_PAIRS):
        q = apply_rope(rms_norm(qkv[:, :, g, 0], q_gain[g]), cos, sin)
        k = apply_rope(rms_norm(qkv[:, :, g, 1], k_gain[g]), cos, sin)
        o, lse = dilated_window_attention(q, k, qkv[:, :, g, 2], window, dilation)
        outs.append(o)
        lses.append(lse)
    wts = jax.nn.softmax(jnp.stack(lses), axis=0)
    o = jnp.einsum('gbsh,gbshd->bshd', wts, jnp.stack(outs))
    return o.reshape(B, S, N_HEADS * HEAD_DIM).astype(hn.dtype) @ w_o


def hierarchical_moe(hn, w_group, b_group, w_expert, b_expert, w_gate, w_up, w_down):
    B, S, D = hn.shape
    T = B * S
    xf = hn.reshape(T, D)
    tok = jnp.arange(T)
    lg = (xf @ w_group + b_group).astype(jnp.float32)
    pg = jax.nn.softmax(lg, axis=-1)
    g_top = jnp.argmax(lg, axis=-1)
    p_top = pg[tok, g_top]
    le_all = (jnp.einsum('td,gde->tge', xf, w_expert) + b_expert).astype(jnp.float32)
    le = le_all[tok, g_top]
    top_v, top_i = lax.top_k(le, TOP_K)
    gates = p_top[:, None] * jax.nn.softmax(top_v, axis=-1)
    eidx = (g_top[:, None] * EXPERTS_PER_GROUP + top_i).astype(jnp.int32)

    A = T * TOP_K
    flat_e = eidx.reshape(A)
    flat_tok = (jnp.arange(A, dtype=jnp.int32) // TOP_K)
    flat_gate = gates.reshape(A)
    order = jnp.argsort(flat_e)
    se = flat_e[order]
    counts = jnp.zeros((N_EXPERTS,), jnp.int32).at[flat_e].add(1)
    padded = (counts + MOE_BLOCK - 1) // MOE_BLOCK * MOE_BLOCK
    pad_end = jnp.cumsum(padded)
    pad_start = pad_end - padded
    start = jnp.cumsum(counts) - counts
    dest = pad_start[se] + jnp.arange(A, dtype=jnp.int32) - start[se]
    n_blocks = (A + N_EXPERTS * (MOE_BLOCK - 1) + MOE_BLOCK - 1) // MOE_BLOCK
    P = n_blocks * MOE_BLOCK
    slot_tok = jnp.zeros((P,), jnp.int32).at[dest].set(flat_tok[order])
    slot_gate = jnp.zeros((P,), jnp.float32).at[dest].set(flat_gate[order])
    block_e = jnp.minimum(
        jnp.searchsorted(pad_end, jnp.arange(n_blocks, dtype=jnp.int32) * MOE_BLOCK, side='right'),
        N_EXPERTS - 1)
    xin = xf[slot_tok].reshape(n_blocks, MOE_BLOCK, D)

    def expert_block(args):
        xb, e = args
        return (jax.nn.silu(xb @ w_gate[e]) * (xb @ w_up[e])) @ w_down[e]

    yb = lax.map(expert_block, (xin, block_e)).reshape(P, D)
    out = jnp.zeros((T, D), hn.dtype).at[slot_tok].add(yb * slot_gate[:, None].astype(yb.dtype))
    return out.reshape(B, S, D)


def per_layer_embedding(h, p_i, w_proj, w_gate, gain):
    e = p_i @ w_proj
    g = jax.nn.sigmoid((h @ w_gate).astype(jnp.float32)).astype(h.dtype)
    return rms_norm(e * g, gain)


def setup_inputs(seed: int = 0) -> dict:
    key = jax.random.key(seed)
    ks = iter(jax.random.split(key, 40))
    f32 = jnp.float32

    def nrm(shape, fan_in):
        return jax.random.normal(next(ks), shape, f32) * (fan_in ** -0.5)

    def gain(shape):
        return 1.0 + 0.05 * jax.random.normal(next(ks), shape, f32)

    def bias(shape, scale=0.02):
        return scale * jax.random.normal(next(ks), shape, f32)

    x = jax.random.normal(next(ks), (BATCH, SEQ, D_MODEL), f32)
    p = jax.random.normal(next(ks), (DEPTH, BATCH, SEQ, PLE_DIM), f32)
    offs = jax.random.randint(next(ks), (BATCH, 1), 0, 1024, dtype=jnp.int32)
    positions = (jnp.arange(SEQ, dtype=jnp.int32)[None, :] + offs).astype(jnp.int32)

    u = jax.random.uniform(next(ks), (N_LRU_LAYERS, D_RNN), f32, 0.9, 0.999)
    a_base = u ** (1.0 / LRU_C)
    lru_lambda = jnp.log(a_base) - jnp.log1p(-a_base)

    return {
        "x": x, "p": p, "positions": positions,
        "norm_mix": gain((DEPTH, D_MODEL)),
        "norm_ffn": gain((DEPTH, D_MODEL)),
        "lru_w_in": nrm((N_LRU_LAYERS, D_MODEL, 2 * D_RNN), D_MODEL),
        "lru_conv_w": nrm((N_LRU_LAYERS, CONV_WIDTH, D_RNN), CONV_WIDTH),
        "lru_conv_b": bias((N_LRU_LAYERS, D_RNN)),
        "lru_w_rg": nrm((N_LRU_LAYERS, N_LRU_BLOCKS, LRU_BLOCK, LRU_BLOCK), LRU_BLOCK),
        "lru_b_rg": bias((N_LRU_LAYERS, N_LRU_BLOCKS, LRU_BLOCK)),
        "lru_w_ig": nrm((N_LRU_LAYERS, N_LRU_BLOCKS, LRU_BLOCK, LRU_BLOCK), LRU_BLOCK),
        "lru_b_ig": bias((N_LRU_LAYERS, N_LRU_BLOCKS, LRU_BLOCK)),
        "lru_lambda": lru_lambda,
        "lru_w_out": nrm((N_LRU_LAYERS, D_RNN, D_MODEL), D_RNN),
        "attn_w_qkv": nrm((N_ATTN_LAYERS, D_MODEL, N_DIL_GROUPS * 3 * N_HEADS * HEAD_DIM), D_MODEL),
        "attn_q_gain": gain((N_ATTN_LAYERS, N_DIL_GROUPS, HEAD_DIM)),
        "attn_k_gain": gain((N_ATTN_LAYERS, N_DIL_GROUPS, HEAD_DIM)),
        "attn_w_o": nrm((N_ATTN_LAYERS, N_HEADS * HEAD_DIM, D_MODEL), N_HEADS * HEAD_DIM),
        "moe_w_group": nrm((DEPTH, D_MODEL, N_GROUPS), D_MODEL),
        "moe_b_group": bias((DEPTH, N_GROUPS), 0.01),
        "moe_w_expert": nrm((DEPTH, N_GROUPS, D_MODEL, EXPERTS_PER_GROUP), D_MODEL),
        "moe_b_expert": bias((DEPTH, N_GROUPS, EXPERTS_PER_GROUP), 0.01),
        "moe_w_gate": nrm((DEPTH, N_EXPERTS, D_MODEL, D_EXPERT), D_MODEL),
        "moe_w_up": nrm((DEPTH, N_EXPERTS, D_MODEL, D_EXPERT), D_MODEL),
        "moe_w_down": nrm((DEPTH, N_EXPERTS, D_EXPERT, D_MODEL), D_EXPERT),
        "ple_w_proj": nrm((DEPTH, PLE_DIM, D_MODEL), PLE_DIM),
        "ple_w_gate": nrm((DEPTH, D_MODEL, D_MODEL), D_MODEL),
        "ple_norm": gain((DEPTH, D_MODEL)),
    }


def reference(x, p, positions, norm_mix, norm_ffn,
              lru_w_in, lru_conv_w, lru_conv_b, lru_w_rg, lru_b_rg, lru_w_ig, lru_b_ig,
              lru_lambda, lru_w_out,
              attn_w_qkv, attn_q_gain, attn_k_gain, attn_w_o,
              moe_w_group, moe_b_group, moe_w_expert, moe_b_expert,
              moe_w_gate, moe_w_up, moe_w_down,
              ple_w_proj, ple_w_gate, ple_norm):
    cos, sin = rope_tables(positions)
    h = x
    for i in range(DEPTH):
        j = i // N_MIXERS
        hn = rms_norm(h, norm_mix[i])
        if i % N_MIXERS == 0:
            mix = rglru_mixer(hn, lru_w_in[j], lru_conv_w[j], lru_conv_b[j],
                              lru_w_rg[j], lru_b_rg[j], lru_w_ig[j], lru_b_ig[j],
                              lru_lambda[j], lru_w_out[j])
        else:
            mix = dilated_attention_mixer(hn, cos, sin, attn_w_qkv[j], attn_q_gain[j],
                                          attn_k_gain[j], attn_w_o[j])
        h = h + mix
        h = h + hierarchical_moe(rms_norm(h, norm_ffn[i]), moe_w_group[i], moe_b_group[i],
                                 moe_w_expert[i], moe_b_expert[i],
                                 moe_w_gate[i], moe_w_up[i], moe_w_down[i])
        h = h + per_layer_embedding(h, p[i].astype(h.dtype), ple_w_proj[i], ple_w_gate[i], ple_norm[i])
    return h
```

```cpp
#include <hip/hip_runtime.h>
#include <cstdio>
#include <cstdint>

#ifndef MK_DUP
#define MK_DUP 0
#endif
#ifndef MK_F8_WOUT
#define MK_F8_WOUT 0
#endif
#ifndef MK_F8_WO
#define MK_F8_WO 1
#endif
#ifndef MK_F8_PROJ
#define MK_F8_PROJ 0
#endif
#ifndef MK_F8_PLEG
#define MK_F8_PLEG 0
#endif
#ifndef MK_N_LAUNCHES
#define MK_N_LAUNCHES 1
#endif

#define DI __device__ __forceinline__
#define LAS __attribute__((address_space(3)))
typedef unsigned short bf16_t;
typedef short bf16x8 __attribute__((ext_vector_type(8)));
typedef short s16x4 __attribute__((ext_vector_type(4)));
typedef float f32x4 __attribute__((ext_vector_type(4)));
typedef unsigned u32x4 __attribute__((ext_vector_type(4)));
typedef unsigned u32x2 __attribute__((ext_vector_type(2)));
typedef int i32x8 __attribute__((ext_vector_type(8)));
typedef short s16x16 __attribute__((ext_vector_type(16)));

constexpr int NB = 2, SEQ = 16384, T = NB * SEQ, DM = 2048, PLE = 256;
constexpr int NQKV = 9216, NHEAD = 8, HD = 128;
constexpr int NEXP = 64, DEXP = 512, SLOTCAP = 32768;
constexpr float EPS = 1e-6f;
constexpr int NPH = 27;
constexpr int N_LAUNCHES = MK_N_LAUNCHES;
static_assert(N_LAUNCHES == 1 || N_LAUNCHES == NPH, "MK_N_LAUNCHES is 1 or 27");

constexpr size_t MiB = 1u << 20;
constexpr size_t WS_CTL = 0, CTL_ZERO_BYTES = 2 * MiB;
constexpr int CW_BAR = 1024;
constexpr int CW_CNT = 8192;
constexpr int CW_ROWSS = 65536;
constexpr size_t WS_RSX = 2 * MiB, WS_RSH3 = 2 * MiB + 256 * 1024, WS_CLAM = 2 * MiB + 512 * 1024;
constexpr size_t WS_W_IN = 4 * MiB, WS_W_G = 20 * MiB, WS_W_OUT = 22 * MiB, WS_W_QKV = 30 * MiB, WS_W_O = 66 * MiB, WS_W_R = 70 * MiB, WS_W_PP = 72 * MiB,
                 WS_W_PG = 74 * MiB, WS_W_GU = 90 * MiB, WS_W_D = 602 * MiB;
constexpr size_t WS_HB = 858 * MiB, WS_PB = 986 * MiB, WS_COS = 1018 * MiB, WS_SIN = 1026 * MiB, WS_LOGITS = 1034 * MiB, WS_SLOT_AID = 1050 * MiB,
                 WS_SLOT_GATE = 1058 * MiB, WS_SP = 1066 * MiB, WS_SH = 1068 * MiB, WS_CIN = 1070 * MiB, WS_LSE = 1072 * MiB, WS_SCR = 1076 * MiB;
constexpr size_t WS_PROJ = WS_SCR, WS_XC = WS_SCR + 256 * MiB, WS_LA = WS_SCR + 384 * MiB, WS_U = WS_SCR + 512 * MiB;
constexpr size_t WS_QKV = WS_SCR, WS_OG = WS_SCR + 576 * MiB, WS_OB = WS_SCR + 768 * MiB;
constexpr size_t WS_HID = WS_SCR, WS_YB = WS_SCR + 80 * MiB, WS_EG = WS_SCR + 336 * MiB;
constexpr size_t WS_H8 = WS_SCR + 832 * MiB;
constexpr size_t WS_END = WS_H8 + 64 * MiB;
static_assert(WS_END <= 2048 * MiB, "workspace map");

constexpr int RING_BYTES = 131072, MISC_OFF = RING_BYTES, LDS_BYTES = 147456;
constexpr int MO_BARW = 0, MO_CNT = 64, MO_MTPRE = 320, MO_T2E = 640, MO_HIST = 1280;

typedef _Float16 h16x2 __attribute__((ext_vector_type(2)));
typedef float f32x2_t __attribute__((ext_vector_type(2)));
typedef __bf16 bf16x2_t __attribute__((ext_vector_type(2)));
DI unsigned cvt_pk_bf16(float lo, float hi) { const f32x2_t v = {lo, hi}; return __builtin_bit_cast(unsigned, __builtin_convertvector(v, bf16x2_t)); }
DI unsigned pk4_fp8(float a, float b, float c, float d) { unsigned w = 0u; w = __builtin_amdgcn_cvt_pk_fp8_f32(a, b, w, false); w = __builtin_amdgcn_cvt_pk_fp8_f32(c, d, w, true); return w; }
DI void unpack8_fp8(const u32x2 w, float (&v)[8]) { const f32x2_t a = __builtin_amdgcn_cvt_pk_f32_fp8(w.x, false), b = __builtin_amdgcn_cvt_pk_f32_fp8(w.x, true), c = __builtin_amdgcn_cvt_pk_f32_fp8(w.y, false), d = __builtin_amdgcn_cvt_pk_f32_fp8(w.y, true);
    v[0] = a[0]; v[1] = a[1]; v[2] = b[0]; v[3] = b[1]; v[4] = c[0]; v[5] = c[1]; v[6] = d[0]; v[7] = d[1]; }
DI float bflo(unsigned w) { return __uint_as_float(w << 16); }
DI float bfhi(unsigned w) { return __uint_as_float(w & 0xffff0000u); }
DI u32x4 pack8(const f32x4 a, const f32x4 b) { u32x4 w; w.x = cvt_pk_bf16(a[0], a[1]); w.y = cvt_pk_bf16(a[2], a[3]); w.z = cvt_pk_bf16(b[0], b[1]); w.w = cvt_pk_bf16(b[2], b[3]); return w; }
DI void unpack8(const u32x4 w, float (&v)[8]) { v[0] = bflo(w.x); v[1] = bfhi(w.x); v[2] = bflo(w.y); v[3] = bfhi(w.y); v[4] = bflo(w.z); v[5] = bfhi(w.z); v[6] = bflo(w.w); v[7] = bfhi(w.w); }
template <int CTRL> DI float dpp_mov(float v) { return __builtin_bit_cast(float, __builtin_amdgcn_update_dpp(0, __builtin_bit_cast(int, v), CTRL, 0xf, 0xf, false)); }
DI float row16_sum(float v) {
    v += dpp_mov<0xB1>(v);
    v += dpp_mov<0x4E>(v);
    v += dpp_mov<0x141>(v);
    v += dpp_mov<0x140>(v);
    return v;
}
DI float row16_xor8(float v) { return dpp_mov<0x128>(v); }
DI float wave_sum(float v) {
#pragma unroll
    for (int o = 1; o < 64; o <<= 1) v += __shfl_xor(v, o);
    return v;
}
typedef unsigned long long rs_t;
constexpr float RS_SCALE = 1048576.0f, RS_INV = 1.0f / (1048576.0f * 2048.0f);
DI rs_t rs_fix(float ss) { return (rs_t)(ss * RS_SCALE + 0.5f); }
DI float rs_rstd(rs_t v) { return __builtin_amdgcn_rsqf((float)v * RS_INV + 1e-6f); }
DI float sigmoidf_(float x) { return __builtin_amdgcn_rcpf(1.0f + __expf(-x)); }
typedef __attribute__((address_space(4))) const unsigned long long ka_u64;
#define GAS __attribute__((address_space(1)))
DI const void* karg_ptr(int i) { ka_u64* kb = (ka_u64*)__builtin_amdgcn_kernarg_segment_ptr(); asm volatile("" : "+s"(kb)); return (const void*)(const GAS void*)kb[i]; }
#define KF(i) ((const float*)karg_ptr(i))
enum { A_X = 0, A_P, A_POS, A_NORM_MIX, A_NORM_FFN, A_W_IN, A_CONV_W, A_CONV_B, A_W_RG, A_B_RG, A_W_IG, A_B_IG, A_LAM, A_W_OUT, A_W_QKV, A_Q_GAIN, A_K_GAIN, A_W_O,
       A_W_GROUP, A_B_GROUP, A_W_EXPERT, A_B_EXPERT, A_W_GATE, A_W_UP, A_W_DOWN, A_PLE_PROJ, A_PLE_GATE, A_PLE_NORM, A_OUT, A_WS };
#define LDS_WAIT() asm volatile("s_waitcnt lgkmcnt(0)" ::: "memory")
#define VM_WAIT() asm volatile("s_waitcnt vmcnt(0)" ::: "memory")

#define XB_TMO      128
#define XB_XCNT(j)  (256  + 64 * (j))
#define XB_XSUB(j)  (1280 + 64 * (j))
#define XB_XGEN(j)  (2304 + 64 * (j))
#define XB_TOP      3328
#define XB_TOPGEN   3392
#define XCD_BAR_WORDS 3456
#define XB_SPIN_CAP (1u << 21)

__device__ __forceinline__ unsigned xb_ld(unsigned* p)              { return __hip_atomic_load(p, __ATOMIC_RELAXED, __HIP_MEMORY_SCOPE_AGENT); }
__device__ __forceinline__ unsigned xb_add(unsigned* p, unsigned v) { return __hip_atomic_fetch_add(p, v, __ATOMIC_RELAXED, __HIP_MEMORY_SCOPE_AGENT); }
__device__ __forceinline__ unsigned xb_xcc_id() { return (unsigned)__builtin_amdgcn_s_getreg((3 << 11) | 20) & 0xFu; }
#define XB_SPIN(cond, bar) do { unsigned _sp = 0; while (cond) { __builtin_amdgcn_s_sleep(1); \
    if ((++_sp & 255u) == 0u) { if (xb_ld(&(bar)[XB_TMO])) break; if (_sp > XB_SPIN_CAP) { atomicAdd(&(bar)[XB_TMO], 1u); break; } } } } while (0)

struct XcdBarrier {
    unsigned* bar; unsigned x;
    volatile LAS unsigned* st;
};
__device__ __forceinline__ XcdBarrier xcd_barrier_post(unsigned* bar, volatile LAS unsigned* st, const int tid) {
    XcdBarrier b; b.bar = bar; b.x = xb_xcc_id(); b.st = st;
    if (tid == 0) (void)xb_add(&bar[XB_XCNT(b.x)], 1u);
    return b;
}
__device__ __forceinline__ void xcd_barrier_complete(unsigned* bar, unsigned x, unsigned& nloc, unsigned& nx) {
    const unsigned G = gridDim.x * gridDim.y * gridDim.z;
    unsigned sum, cnt, mine, sp = 0u;
    for (;;) {
        sum = 0u; cnt = 0u; mine = 0u;
#pragma unroll
        for (unsigned j = 0; j < 16; ++j) { const unsigned c = xb_ld(&bar[XB_XCNT(j)]); sum += c; cnt += (c > 0u) ? 1u : 0u; mine = (j == x) ? c : mine; }
        if (sum == G) break;
        __builtin_amdgcn_s_sleep(1);
        if ((++sp & 255u) == 0u) { if (xb_ld(&bar[XB_TMO])) break; if (sp > XB_SPIN_CAP) { atomicAdd(&bar[XB_TMO], 1u); break; } }
    }
    nloc = mine > 0u ? mine : 1u; nx = cnt > 0u ? cnt : 1u;
}
__device__ __forceinline__ void xcd_barrier(const XcdBarrier& b, const int tid) {
    asm volatile("s_waitcnt vmcnt(0)" ::: "memory");
    __syncthreads();
    if (tid == 0) {
        unsigned* bar = b.bar;
        __builtin_amdgcn_s_waitcnt(0);
        unsigned nloc = b.st[0], nx = b.st[1];
        if (nloc == 0u) { xcd_barrier_complete(bar, b.x, nloc, nx); b.st[0] = nloc; b.st[1] = nx; }
        const unsigned old = xb_add(&bar[XB_XSUB(b.x)], 1u);
        const unsigned gen = old / nloc;
        if (old + 1u == (gen + 1u) * nloc) {
            __builtin_amdgcn_fence(__ATOMIC_RELEASE, "agent");
            asm volatile("s_waitcnt vmcnt(0)" ::: "memory");
            const unsigned og = xb_add(&bar[XB_TOP], 1u);
            const unsigned tg = og / nx;
            if (og + 1u == (tg + 1u) * nx) xb_add(&bar[XB_TOPGEN], 1u);
            else XB_SPIN(xb_ld(&bar[XB_TOPGEN]) == tg, bar);
            __builtin_amdgcn_fence(__ATOMIC_ACQUIRE, "agent");
            xb_add(&bar[XB_XGEN(b.x)], 1u);
            asm volatile("s_waitcnt vmcnt(0)" ::: "memory");
        } else {
            XB_SPIN(xb_ld(&bar[XB_XGEN(b.x)]) == gen, bar);
            __builtin_amdgcn_fence(__ATOMIC_ACQUIRE, "agent");
            asm volatile("s_waitcnt vmcnt(0)" ::: "memory");
        }
    }
    __syncthreads();
}

namespace g8 {
constexpr int BM = 256, BK = 64, HALF = 128, HTB = HALF * BK * 2, NXCD = 8, WGM = 8;
DI int lds_byte(int r, int c) { const int st = (r >> 4) * 2 + (c >> 5), rr = r & 15, cc = c & 31, ob = rr * 64 + cc * 2; return st * 1024 + (ob ^ (((ob >> 9) & 1) << 5)); }
DI void stage_rc(int b, int& R, int& C) { const int st = b / 1024, sb = b % 1024, swz = sb ^ (((sb >> 9) & 1) << 5); R = (st >> 1) * 16 + swz / 64; C = (st & 1) * 32 + (swz % 64) / 2; }
DI int perm32(int rho) { const int n = rho >> 4, i = rho & 15; return 8 * (i >> 2) + 4 * n + (i & 3); }

struct Unit { const char* a; const char* b; int r0, c0, x0, x1, x2; };

DI int xcd_remap(int L, int nwg) { const int q = nwg / NXCD, r = nwg % NXCD, xcd = L % NXCD, off = L / NXCD; return (xcd < r ? xcd * (q + 1) : r * (q + 1) + (xcd - r) * q) + off; }

struct StaticSched {
    static constexpr bool GATHER = false;
    const char* A; const char* B; unsigned lda, ldb; int nM, nN, nwg, G, c;
    DI void init(const void* A_, unsigned lda_, const void* B_, unsigned ldb_, int nM_, int nN_, int G_, int c_) { A = (const char*)A_; B = (const char*)B_; lda = lda_; ldb = ldb_; nM = nM_; nN = nN_; nwg = nM * nN; G = G_; c = c_; }
    DI bool next(int i, Unit& u) const {
        const int L = i * G + c; if (L >= nwg) return false;
        const int wgid = xcd_remap(L, nwg);
        const int nig = WGM * nN, gid = wgid / nig, fm = gid * WGM, gsz = (nM - fm) < WGM ? (nM - fm) : WGM;
        const int pm = fm + ((wgid % nig) % gsz), pn = (wgid % nig) / gsz;
        u.a = A + (size_t)pm * 256 * lda; u.b = B + (size_t)pn * 256 * ldb; u.r0 = pm * 256; u.c0 = pn * 256; u.x0 = 0; u.x1 = 0; u.x2 = 0; return true;
    }
    DI unsigned gather(const Unit&, int) const { return 0u; }
};
struct GateSched {
    static constexpr bool GATHER = false;
    const char* A; const char* B; int nwg, G, c;
    DI void init(const void* A_, const void* B_, int G_, int c_) { A = (const char*)A_; B = (const char*)B_; nwg = (T / 256) * 16; G = G_; c = c_; }
    DI bool next(int i, Unit& u) const {
        const int L = i * G + c; if (L >= nwg) return false;
        const int wgid = xcd_remap(L, nwg);
        const int nN = 16, nM = T / 256, nig = WGM * nN, gid = wgid / nig, fm = gid * WGM, gsz = (nM - fm) < WGM ? (nM - fm) : WGM;
        const int pm = fm + ((wgid % nig) % gsz), pn = (wgid % nig) / gsz, blk = pn >> 1, j = pn & 1;
        u.a = A + (size_t)pm * 256 * (DM * 2) + blk * 512; u.b = B + (size_t)pn * 256 * 512; u.r0 = pm * 256; u.c0 = blk * 256 + j * 128; u.x0 = 0; u.x1 = 0; u.x2 = 0; return true;
    }
    DI unsigned gather(const Unit&, int) const { return 0u; }
};
template <int NJ, bool GATH> struct MoeSched {
    static constexpr bool GATHER = GATH;
    const char* A; const char* B; unsigned lda, ldbt  ; size_t bexp  ; const int* slot_aid; LAS unsigned char* misc; int nwg, G, c;
    DI void init(const void* A_, unsigned lda_, const void* B_, unsigned ldb_, size_t bexp_, const int* slot_aid_, LAS unsigned char* misc_, int G_, int c_) {
        A = (const char*)A_; lda = lda_; B = (const char*)B_; ldbt = 256u * ldb_; bexp = bexp_; slot_aid = slot_aid_; misc = misc_; G = G_; c = c_;
        nwg = ((const LAS int*)(misc + MO_MTPRE))[64] * NJ; }
    DI bool next(int i, Unit& u) const {
        const int L = i * G + c; if (L >= nwg) return false;
        const int idx = xcd_remap(L, nwg), mt = idx / NJ, j = idx % NJ;
        const int e = __builtin_amdgcn_readfirstlane((int)((const LAS unsigned char*)(misc + MO_T2E))[mt]);
        const int pre = __builtin_amdgcn_readfirstlane(((const LAS int*)(misc + MO_MTPRE))[e]);
        const int cn = __builtin_amdgcn_readfirstlane(((const LAS int*)(misc + MO_CNT))[e]);
        const int pos0 = (mt - pre) * 256;
        u.a = GATH ? A : A + (size_t)mt * 256 * lda; u.b = B + (size_t)e * bexp + (size_t)j * ldbt;
        u.r0 = mt * 256; u.c0 = j; u.x0 = e * SLOTCAP + pos0; u.x1 = pos0; u.x2 = cn - pos0; return true;
    }
    DI unsigned gather(const Unit& u, int row) const { const int rc = row < u.x2 ? row : u.x2 - 1; const int aid = slot_aid[u.x0 + rc]; return (unsigned)(aid >> 1) * lda; }
};

template <class Epi, class Sched>
DI void gemm_phase(LAS unsigned char* lds, const int tid, const int K, const unsigned lda, const unsigned ldb, const Sched& S, const Epi& E) {
    const int wid = __builtin_amdgcn_readfirstlane(tid >> 6), lane = tid & 63, wr = wid >> 2, wc = wid & 3, fr = lane & 15, fq = lane >> 4;
    const int nt = K / BK;
    unsigned voffA[2], voffB[2]; int rowA[2]; unsigned colA[2];
#pragma unroll
    for (int i = 0; i < 2; ++i) { int R, C; stage_rc(tid * 16 + i * 8192, R, C); const int Rb = Epi::PERM ? ((R & ~31) + perm32(R & 31)) : R;
        voffA[i] = (unsigned)R * lda + (unsigned)C * 2u; voffB[i] = (unsigned)Rb * ldb + (unsigned)C * 2u; rowA[i] = R; colA[i] = (unsigned)C * 2u; }
    const size_t kstep = (size_t)(BK * 2);
    const size_t hA = (size_t)HALF * lda, hB = (size_t)HALF * ldb;
    const unsigned ldsw = (unsigned)wid * 1024u;
    constexpr bool FP8 = Epi::FP8; constexpr bool HALFN = Epi::HALFN;
    const int aoff = lds_byte(wr * 64 + fr, FP8 ? fq * 16 : fq * 8), boff = lds_byte(wc * 32 + fr, FP8 ? fq * 16 : fq * 8);
    unsigned gc[2][2] = {{0u, 0u}, {0u, 0u}}, gn[2][2] = {{0u, 0u}, {0u, 0u}};
#define G8_SA(b, h) (((b) * 2 + (h)) * HTB)
#define G8_SB(b, h) ((4 + (b) * 2 + (h)) * HTB)
#define G8_GLDS(gp, ldsoff) __builtin_amdgcn_global_load_lds((const unsigned*)(gp), (LAS unsigned*)(lds + (ldsoff)), 16, 0, 0)
#define G8_STAGE_B(bufoff, gbase) do { G8_GLDS((gbase) + voffB[0], (bufoff) + ldsw); G8_GLDS((gbase) + voffB[1], (bufoff) + ldsw + 8192); } while (0)
#define G8_STAGE_A(bufoff, kptr, h, nx) do { if constexpr (Sched::GATHER) { \
        const unsigned o0_ = (nx) ? gn[h][0] : gc[h][0], o1_ = (nx) ? gn[h][1] : gc[h][1]; \
        G8_GLDS((kptr) + o0_, (bufoff) + ldsw); G8_GLDS((kptr) + o1_, (bufoff) + ldsw + 8192); } \
    else { G8_GLDS((kptr) + (h) * hA + voffA[0], (bufoff) + ldsw); G8_GLDS((kptr) + (h) * hA + voffA[1], (bufoff) + ldsw + 8192); } } while (0)
#define G8_LDA(b, h) do { if constexpr (FP8) { _Pragma("unroll") for (int m = 0; m < 4; ++m) { const bf16x8 lo_ = *(const LAS bf16x8*)(lds + G8_SA(b, h) + aoff + m * 2048), hi_ = *(const LAS bf16x8*)(lds + G8_SA(b, h) + aoff + m * 2048 + 16); A8[m] = __builtin_bit_cast(i32x8, __builtin_shufflevector(lo_, hi_, 0, 1, 2, 3, 4, 5, 6, 7, 8, 9, 10, 11, 12, 13, 14, 15)); } } \
    else { _Pragma("unroll") for (int m = 0; m < 4; ++m) _Pragma("unroll") for (int k = 0; k < 2; ++k) At[m][k] = *(const LAS bf16x8*)(lds + G8_SA(b, h) + aoff + m * 2048 + k * 1024); } } while (0)
#define G8_LDB(w, b, h) do { if constexpr (FP8) { _Pragma("unroll") for (int n = 0; n < 2; ++n) { const bf16x8 lo_ = *(const LAS bf16x8*)(lds + G8_SB(b, h) + boff + n * 2048), hi_ = *(const LAS bf16x8*)(lds + G8_SB(b, h) + boff + n * 2048 + 16); B8[w][n] = __builtin_bit_cast(i32x8, __builtin_shufflevector(lo_, hi_, 0, 1, 2, 3, 4, 5, 6, 7, 8, 9, 10, 11, 12, 13, 14, 15)); } } \
    else { _Pragma("unroll") for (int n = 0; n < 2; ++n) _Pragma("unroll") for (int k = 0; k < 2; ++k) Bq[w][n][k] = *(const LAS bf16x8*)(lds + G8_SB(b, h) + boff + n * 2048 + k * 1024); } } while (0)
#define G8_MMA(ai, bj, w) do { __builtin_amdgcn_s_setprio(1); if constexpr (FP8) { _Pragma("unroll") for (int m = 0; m < 4; ++m) _Pragma("unroll") for (int n = 0; n < 2; ++n) \
        asm volatile("v_mfma_scale_f32_16x16x128_f8f6f4 %0, %1, %2, %0, %3, %3 op_sel_hi:[0,0,0]" : "+v"(acc[ai][bj][m][n]) : "v"(B8[w][n]), "v"(A8[m]), "v"(one_scale)); } \
    else { _Pragma("unroll") for (int m = 0; m < 4; ++m) _Pragma("unroll") for (int n = 0; n < 2; ++n) _Pragma("unroll") for (int k = 0; k < 2; ++k) \
        acc[ai][bj][m][n] = __builtin_amdgcn_mfma_f32_16x16x32_bf16(Bq[w][n][k], At[m][k], acc[ai][bj][m][n], 0, 0, 0); } __builtin_amdgcn_s_setprio(0); } while (0)
#define G8_WAIT_V(n) asm volatile("s_waitcnt vmcnt(" #n ")" ::: "memory")
#define G8_WAIT_L(n) asm volatile("s_waitcnt lgkmcnt(" #n ")" ::: "memory")
#define G8_BAR __builtin_amdgcn_s_barrier()
#define G8_SCHED __builtin_amdgcn_sched_barrier(0)
#define G8_GOFF(dst, u) do { if constexpr (Sched::GATHER) { _Pragma("unroll") for (int h_ = 0; h_ < 2; ++h_) _Pragma("unroll") for (int i_ = 0; i_ < 2; ++i_) dst[h_][i_] = S.gather(u, h_ * 128 + rowA[i_]) + colA[i_]; } } while (0)
    Unit cur, nxt; int ui = 0;
    if (!S.next(0, cur)) return;
    f32x4 acc[2][2][4][2];
#pragma unroll
    for (int a = 0; a < 2; ++a)
#pragma unroll
        for (int b = 0; b < 2; ++b)
#pragma unroll
            for (int m = 0; m < 4; ++m)
#pragma unroll
                for (int n = 0; n < 2; ++n) acc[a][b][m][n] = (f32x4){0.f, 0.f, 0.f, 0.f};
    bf16x8 At[4][2], Bq[2][2][2]; i32x8 A8[4], B8[2][2];
    const int one_scale = 0x7f7f7f7f;
    const char* cA = cur.a; const char* cB = cur.b;
    G8_GOFF(gc, cur);
    G8_STAGE_B(G8_SB(0, 0), cB); G8_STAGE_B(G8_SB(0, 1), cB + hB); G8_STAGE_A(G8_SA(0, 0), cA, 0, false); G8_STAGE_A(G8_SA(0, 1), cA, 1, false);
    if (wr == 1) G8_BAR;
    G8_WAIT_V(2); G8_BAR;
    G8_STAGE_B(G8_SB(1, 0), cB + kstep); G8_STAGE_A(G8_SA(1, 0), cA + kstep, 0, false); G8_STAGE_B(G8_SB(1, 1), cB + hB + kstep);
    G8_WAIT_V(6); G8_BAR;
    for (;;) {
        const bool has_next = S.next(ui + 1, nxt);
        const char* nA = has_next ? nxt.a : cA; const char* nB = has_next ? nxt.b : cB;
        if constexpr (Sched::GATHER) { if (has_next) { G8_GOFF(gn, nxt); } else {
#pragma unroll
            for (int h_ = 0; h_ < 2; ++h_)
#pragma unroll
                for (int i_ = 0; i_ < 2; ++i_) gn[h_][i_] = gc[h_][i_]; } }
        for (int t = 0; t < nt; t += 2) {
            const bool last = (t == nt - 2);
            const char* a1 = cA + (size_t)(t + 1) * kstep;
            const char* a2 = last ? nA : cA + (size_t)(t + 2) * kstep; const char* b2 = last ? nB : cB + (size_t)(t + 2) * kstep;
            const char* a3 = a2 + kstep; const char* b3 = b2 + kstep;
            G8_LDB(0, 0, 0); if constexpr (!HALFN) G8_LDB(1, 0, 1); G8_SCHED; G8_LDA(0, 0); G8_STAGE_A(G8_SA(1, 1), a1, 1, false);
            G8_WAIT_V(8); G8_WAIT_L(0); G8_BAR; G8_MMA(0, 0, 0); if constexpr (!HALFN) G8_MMA(0, 1, 1); G8_BAR; G8_SCHED;
            G8_LDA(0, 1); G8_STAGE_B(G8_SB(0, 0), b2); G8_STAGE_B(G8_SB(0, 1), b2 + hB); G8_STAGE_A(G8_SA(0, 0), a2, 0, last);
            G8_WAIT_V(8); G8_WAIT_L(0); G8_BAR; G8_MMA(1, 0, 0); if constexpr (!HALFN) G8_MMA(1, 1, 1); G8_BAR; G8_SCHED;
            G8_LDB(0, 1, 0); if constexpr (!HALFN) G8_LDB(1, 1, 1); G8_SCHED; G8_LDA(1, 0); G8_STAGE_A(G8_SA(0, 1), a2, 1, last);
            G8_WAIT_V(8); G8_WAIT_L(0); G8_BAR; G8_MMA(0, 0, 0); if constexpr (!HALFN) G8_MMA(0, 1, 1); G8_BAR; G8_SCHED;
            G8_LDA(1, 1); G8_STAGE_B(G8_SB(1, 0), b3); G8_STAGE_B(G8_SB(1, 1), b3 + hB); G8_STAGE_A(G8_SA(1, 0), a3, 0, last);
            G8_WAIT_V(8); G8_WAIT_L(0); G8_BAR; G8_MMA(1, 0, 0); if constexpr (!HALFN) G8_MMA(1, 1, 1); G8_BAR; G8_SCHED;
        }
        if (wr == 0) G8_BAR;
        if constexpr (FP8) asm volatile("s_nop 15\n\ts_nop 15" ::: "memory");
        { int l2 = (int)__builtin_amdgcn_mbcnt_hi(~0u, __builtin_amdgcn_mbcnt_lo(~0u, 0u)); asm volatile("" : "+v"(l2));
          E(acc, cur, wr, wc, l2 & 15, l2 >> 4); }
        if (!has_next) break;
#pragma unroll
        for (int a = 0; a < 2; ++a)
#pragma unroll
            for (int b = 0; b < 2; ++b)
#pragma unroll
                for (int m = 0; m < 4; ++m)
#pragma unroll
                    for (int n = 0; n < 2; ++n) acc[a][b][m][n] = (f32x4){0.f, 0.f, 0.f, 0.f};
        cur = nxt; cA = nA; cB = nB; ++ui;
        if constexpr (Sched::GATHER) {
#pragma unroll
            for (int h_ = 0; h_ < 2; ++h_)
#pragma unroll
                for (int i_ = 0; i_ < 2; ++i_) gc[h_][i_] = gn[h_][i_]; }
        if (wr == 1) G8_BAR;
    }
    G8_WAIT_V(0);
    G8_BAR;
#undef G8_SA
#undef G8_SB
#undef G8_GLDS
#undef G8_STAGE_A
#undef G8_STAGE_B
#undef G8_LDA
#undef G8_LDB
#undef G8_MMA
#undef G8_WAIT_V
#undef G8_WAIT_L
#undef G8_BAR
#undef G8_SCHED
#undef G8_GOFF
}

#define EPI_ROWS(ai, m) ((ai) * 128 + wr * 64 + (m) * 16 + fr)

template <bool F8> struct EpiBf16ScaleT {
    static constexpr bool PERM = true; static constexpr bool FP8 = F8; static constexpr bool HALFN = false;
    bf16_t* O; int ldc; const rs_t* rowss; float mul;
    DI void operator()(const f32x4 (&acc)[2][2][4][2], const Unit& u, int wr, int wc, int fr, int fq) const {
        rs_t rs[2][4];
#pragma unroll
        for (int ai = 0; ai < 2; ++ai)
#pragma unroll
            for (int m = 0; m < 4; ++m) rs[ai][m] = rowss ? rowss[u.r0 + EPI_ROWS(ai, m)] : 0ull;
#pragma unroll
        for (int ai = 0; ai < 2; ++ai)
#pragma unroll
            for (int m = 0; m < 4; ++m) {
                const int row = u.r0 + EPI_ROWS(ai, m);
                const float sc = (rowss ? rs_rstd(rs[ai][m]) : 1.0f) * mul;
                bf16_t* rowp = O + (size_t)row * ldc + u.c0 + wc * 32 + 8 * fq;
#pragma unroll
                for (int bj = 0; bj < 2; ++bj) *(u32x4*)(rowp + bj * 128) = pack8(acc[ai][bj][m][0] * sc, acc[ai][bj][m][1] * sc);
            }
    }
};
typedef EpiBf16ScaleT<false> EpiBf16Scale;
DI int qkv_plane_row(int t, int dsh) { const int b = t >> 14, sp = t & (SEQ - 1); return (b << 14) + (sp & ((1 << dsh) - 1)) * (SEQ >> dsh) + (sp >> dsh); }
struct EpiQkvPlanes {
    static constexpr bool PERM = true; static constexpr bool FP8 = true; static constexpr bool HALFN = false;
    unsigned char* O; const rs_t* rowss; float mul;
    DI void operator()(const f32x4 (&acc)[2][2][4][2], const Unit& u, int wr, int wc, int fr, int fq) const {
        const int pn = u.c0 >> 8, g = pn / 12, dsh = 2 * g;
        const size_t plane0 = (size_t)(pn >> 2) * 8 + (pn & 3) * 2;
        rs_t rs[2][4];
#pragma unroll
        for (int ai = 0; ai < 2; ++ai)
#pragma unroll
            for (int m = 0; m < 4; ++m) rs[ai][m] = rowss[u.r0 + EPI_ROWS(ai, m)];
#pragma unroll
        for (int ai = 0; ai < 2; ++ai)
#pragma unroll
            for (int m = 0; m < 4; ++m) {
                const int prow = qkv_plane_row(u.r0 + EPI_ROWS(ai, m), dsh);
                const float sc = rs_rstd(rs[ai][m]) * mul;
                unsigned char* rowp = O + (plane0 * T + prow) * HD + wc * 32 + 8 * fq;
#pragma unroll
                for (int bj = 0; bj < 2; ++bj) { const f32x4 a0 = acc[ai][bj][m][0] * sc, a1 = acc[ai][bj][m][1] * sc; u32x2 q; q.x = pk4_fp8(a0[0], a0[1], a0[2], a0[3]); q.y = pk4_fp8(a1[0], a1[1], a1[2], a1[3]); *(u32x2*)(rowp + (size_t)bj * T * HD) = q; }
            }
    }
};
struct EpiGates {
    static constexpr bool PERM = true; static constexpr bool FP8 = false; static constexpr bool HALFN = false;
    const bf16_t* XC; const float* b_rg; const float* b_ig; const float* clam; bf16_t* LA; bf16_t* U;
    DI void operator()(const f32x4 (&acc)[2][2][4][2], const Unit& u, int wr, int wc, int fr, int fq) const {
        const int ch = u.c0 + wc * 32 + 8 * fq;
        float br[8], bi[8], cl[8];
        { const f32x4 a = *(const f32x4*)(b_rg + ch), b = *(const f32x4*)(b_rg + ch + 4), c = *(const f32x4*)(b_ig + ch), d = *(const f32x4*)(b_ig + ch + 4), e = *(const f32x4*)(clam + ch), f = *(const f32x4*)(clam + ch + 4);
#pragma unroll
          for (int j = 0; j < 4; ++j) { br[j] = a[j]; br[4 + j] = b[j]; bi[j] = c[j]; bi[4 + j] = d[j]; cl[j] = e[j]; cl[4 + j] = f[j]; } }
        const unsigned off0 = ((unsigned)(u.r0 + wr * 64 + fr) * DM + (unsigned)ch) * 2u;
#pragma unroll
        for (int ai = 0; ai < 2; ++ai)
#pragma unroll
            for (int m = 0; m < 4; ++m) {
                const unsigned off = off0 + (unsigned)((ai * 128 + m * 16) * DM * 2);
                float xv[8]; unpack8(*(const u32x4*)((const char*)XC + off), xv);
                float la[8], uu[8];
#pragma unroll
                for (int j = 0; j < 8; ++j) {
                    const float r = sigmoidf_(acc[ai][0][m][j >> 2][j & 3] + br[j]), ig = sigmoidf_(acc[ai][1][m][j >> 2][j & 3] + bi[j]);
                    const float l = r * cl[j];
                    la[j] = l;
                    const float om = 1.0f - __expf(2.0f * l);
                    uu[j] = __builtin_amdgcn_sqrtf(om > 0.f ? om : 0.f) * (ig * xv[j]);
                }
                u32x4 lw = pack8((f32x4){la[0], la[1], la[2], la[3]}, (f32x4){la[4], la[5], la[6], la[7]});
                u32x4 uw = pack8((f32x4){uu[0], uu[1], uu[2], uu[3]}, (f32x4){uu[4], uu[5], uu[6], uu[7]});
                asm volatile("" : "+v"(lw), "+v"(uw));
                *(u32x4*)((char*)LA + off) = lw; *(u32x4*)((char*)U + off) = uw;
                asm volatile("" ::: "memory");
            }
    }
};
template <bool F8> struct EpiResidT {
    static constexpr bool PERM = true; static constexpr bool FP8 = F8; static constexpr bool HALFN = false;
    bf16_t* hb; unsigned char* h8; rs_t* rowss; float mul;
    DI void operator()(const f32x4 (&acc)[2][2][4][2], const Unit& u, int wr, int wc, int fr, int fq) const {
        const unsigned off0 = ((unsigned)(u.r0 + wr * 64 + fr) * DM + (unsigned)(u.c0 + wc * 32 + 8 * fq)) * 2u;
#pragma unroll
        for (int ai = 0; ai < 2; ++ai)
#pragma unroll
            for (int m = 0; m < 4; ++m) {
                const int row = u.r0 + EPI_ROWS(ai, m);
                const unsigned off = off0 + (unsigned)((ai * 128 + m * 16) * DM * 2);
                float ss = 0.f;
#pragma unroll
                for (int bj = 0; bj < 2; ++bj) {
                    float rv[8]; unpack8(*(const u32x4*)((const char*)hb + off + bj * 256), rv);
                    const f32x4 h0 = (f32x4){rv[0], rv[1], rv[2], rv[3]} + acc[ai][bj][m][0] * mul, h1 = (f32x4){rv[4], rv[5], rv[6], rv[7]} + acc[ai][bj][m][1] * mul;
                    *(u32x4*)((char*)hb + off + bj * 256) = pack8(h0, h1);
                    { u32x2 q; q.x = pk4_fp8(h0[0], h0[1], h0[2], h0[3]); q.y = pk4_fp8(h1[0], h1[1], h1[2], h1[3]); *(u32x2*)(h8 + (off >> 1) + bj * 128) = q; }
                    ss += (h0[0] * h0[0] + h0[1] * h0[1]) + (h0[2] * h0[2] + h0[3] * h0[3]) + (h1[0] * h1[0] + h1[1] * h1[1]) + (h1[2] * h1[2] + h1[3] * h1[3]);
                }
                ss += __shfl_xor(ss, 16); ss += __shfl_xor(ss, 32);
                if (fq == 0) atomicAdd(rowss + row, rs_fix(ss));
            }
    }
};
struct EpiLogits {
    static constexpr bool PERM = false; static constexpr bool FP8 = false; static constexpr bool HALFN = true;
    float* L; const rs_t* rowss;
    DI void operator()(const f32x4 (&acc)[2][2][4][2], const Unit& u, int wr, int wc, int fr, int fq) const {
        rs_t rs[2][4];
#pragma unroll
        for (int ai = 0; ai < 2; ++ai)
#pragma unroll
            for (int m = 0; m < 4; ++m) rs[ai][m] = rowss[u.r0 + EPI_ROWS(ai, m)];
#pragma unroll
        for (int ai = 0; ai < 2; ++ai)
#pragma unroll
            for (int m = 0; m < 4; ++m) {
                const int row = u.r0 + EPI_ROWS(ai, m);
                const float sc = rs_rstd(rs[ai][m]);
                float* rowp = L + (size_t)row * 128 + wc * 32 + 4 * fq;
#pragma unroll
                for (int n = 0; n < 2; ++n) *(f32x4*)(rowp + n * 16) = acc[ai][0][m][n] * sc;
            }
    }
};
struct EpiGU {
    static constexpr bool PERM = true; static constexpr bool FP8 = true; static constexpr bool HALFN = false;
    unsigned char* HID; const int* slot_aid; const rs_t* rowss;
    DI void operator()(const f32x4 (&acc)[2][2][4][2], const Unit& u, int wr, int wc, int fr, int fq) const {
        int aid[2][4]; rs_t rs[2][4];
#pragma unroll
        for (int ai = 0; ai < 2; ++ai)
#pragma unroll
            for (int m = 0; m < 4; ++m) { const int rt = EPI_ROWS(ai, m); aid[ai][m] = slot_aid[u.x0 + (rt < u.x2 ? rt : u.x2 - 1)]; }
#pragma unroll
        for (int ai = 0; ai < 2; ++ai)
#pragma unroll
            for (int m = 0; m < 4; ++m) rs[ai][m] = rowss[aid[ai][m] >> 1];
#pragma unroll
        for (int ai = 0; ai < 2; ++ai)
#pragma unroll
            for (int m = 0; m < 4; ++m) {
                const int rt = EPI_ROWS(ai, m);
                const float sc = rs_rstd(rs[ai][m]) * (1.0f / 64.0f);
                f32x4 h[2];
#pragma unroll
                for (int n = 0; n < 2; ++n)
#pragma unroll
                    for (int j = 0; j < 4; ++j) { const float g = acc[ai][0][m][n][j] * sc, v = acc[ai][1][m][n][j] * sc; h[n][j] = g * sigmoidf_(g) * v; }
                u32x2 q; q.x = pk4_fp8(h[0][0], h[0][1], h[0][2], h[0][3]); q.y = pk4_fp8(h[1][0], h[1][1], h[1][2], h[1][3]);
                *(u32x2*)(HID + (size_t)(u.r0 + rt) * DEXP + u.c0 * 128 + wc * 32 + 8 * fq) = q;
            }
    }
};
struct EpiDown {
    static constexpr bool PERM = true; static constexpr bool FP8 = true; static constexpr bool HALFN = false;
    unsigned char* YB; const int* slot_aid; const float* slot_gate;
    DI void operator()(const f32x4 (&acc)[2][2][4][2], const Unit& u, int wr, int wc, int fr, int fq) const {
        int aid[2][4]; float gt[2][4];
#pragma unroll
        for (int ai = 0; ai < 2; ++ai)
#pragma unroll
            for (int m = 0; m < 4; ++m) { const int rt = EPI_ROWS(ai, m), rc = rt < u.x2 ? rt : u.x2 - 1; aid[ai][m] = slot_aid[u.x0 + rc]; gt[ai][m] = slot_gate[u.x0 + rc] * (16.0f / 64.0f); }
#pragma unroll
        for (int ai = 0; ai < 2; ++ai)
#pragma unroll
            for (int m = 0; m < 4; ++m) {
                const int rt = EPI_ROWS(ai, m);
                if (rt < u.x2) {
                    unsigned char* rowp = YB + (size_t)aid[ai][m] * DM + u.c0 * 256 + wc * 32 + 8 * fq;
#pragma unroll
                    for (int bj = 0; bj < 2; ++bj) { const f32x4 a0 = acc[ai][bj][m][0] * gt[ai][m], a1 = acc[ai][bj][m][1] * gt[ai][m]; u32x2 q; q.x = pk4_fp8(a0[0], a0[1], a0[2], a0[3]); q.y = pk4_fp8(a1[0], a1[1], a1[2], a1[3]); *(u32x2*)(rowp + bj * 128) = q; }
                }
            }
    }
};
template <bool F8> struct EpiPleGT {
    static constexpr bool PERM = true; static constexpr bool FP8 = F8; static constexpr bool HALFN = false;
    bf16_t* EG; rs_t* rowss; float mul;
    DI void operator()(const f32x4 (&acc)[2][2][4][2], const Unit& u, int wr, int wc, int fr, int fq) const {
#pragma unroll
        for (int ai = 0; ai < 2; ++ai)
#pragma unroll
            for (int m = 0; m < 4; ++m) {
                const int row = u.r0 + EPI_ROWS(ai, m);
                bf16_t* rowp = EG + (size_t)row * DM + u.c0 + wc * 32 + 8 * fq;
                float ss = 0.f;
#pragma unroll
                for (int bj = 0; bj < 2; ++bj) {
                    float ev[8]; unpack8(*(const u32x4*)(rowp + bj * 128), ev);
                    f32x4 o[2];
#pragma unroll
                    for (int j = 0; j < 8; ++j) { const float v = ev[j] * sigmoidf_(acc[ai][bj][m][j >> 2][j & 3] * mul); o[j >> 2][j & 3] = v; ss += v * v; }
                    *(u32x4*)(rowp + bj * 128) = pack8(o[0], o[1]);
                }
                ss += __shfl_xor(ss, 16); ss += __shfl_xor(ss, 32);
                if (fq == 0) atomicAdd(rowss + row, rs_fix(ss));
            }
    }
};
}

struct Ctx { LAS unsigned char* lds; int tid, lane, wave, G, bid; };

struct TrJob { const float* src; const float* gain; bf16_t* dst; int N, Kd; int f8; };
DI void tr_load(float (&v)[32], const TrJob& j, int lane) {
#pragma unroll
    for (int i = 0; i < 32; ++i) { const int kk = 2 * i + (lane >> 5); v[i] = j.src[(size_t)kk * j.N + (lane & 31)]; }
}
DI void tr_store(const float (&v)[32], const TrJob& jb, LAS float* scr, int lane) {
#pragma unroll
    for (int i = 0; i < 32; ++i) { const int kk = 2 * i + (lane >> 5); scr[kk * 33 + (lane & 31)] = v[i]; }
    LDS_WAIT(); asm volatile("" ::: "memory");
    const int c = lane & 7;
    float g[8];
#pragma unroll
    for (int j = 0; j < 8; ++j) g[j] = jb.gain ? jb.gain[8 * c + j] : 1.0f;
#pragma unroll
    for (int j = 0; j < 4; ++j) { const int n = (lane >> 3) + 8 * j; const LAS float* s = scr + (8 * c) * 33 + n;
        float t[8];
#pragma unroll
        for (int q = 0; q < 8; ++q) t[q] = s[q * 33] * g[q];
        if (jb.f8) { u32x2 o; o.x = pk4_fp8(t[0] * 64.f, t[1] * 64.f, t[2] * 64.f, t[3] * 64.f); o.y = pk4_fp8(t[4] * 64.f, t[5] * 64.f, t[6] * 64.f, t[7] * 64.f);
            *(u32x2*)((unsigned char*)jb.dst + (size_t)n * jb.Kd + 8 * c) = o; }
        else { u32x4 o; o.x = cvt_pk_bf16(t[0], t[1]); o.y = cvt_pk_bf16(t[2], t[3]); o.z = cvt_pk_bf16(t[4], t[5]); o.w = cvt_pk_bf16(t[6], t[7]);
            *(u32x4*)(jb.dst + (size_t)n * jb.Kd + 8 * c) = o; } }
    LDS_WAIT(); asm volatile("" ::: "memory");
}
DI void p0_prologue(const Ctx& F, unsigned char* ws) {
    LAS float* scr = (LAS float*)(F.lds + F.wave * 8704);
    const int gw = F.bid * 8 + F.wave, NGW = F.G * 8;
    const int gt = F.bid * 512 + F.tid, NGT = F.G * 512;
    constexpr int I_IN = 32 * 128, I_G = 8 * 4 * 8, I_OUT = 32 * 64, I_QKV = 32 * 288, I_O = 16 * 64, I_PP = 4 * 64, I_PG = 32 * 64, I_ME = 512;
    constexpr int N_SMALL = I_IN + 2 * I_G + I_OUT + I_QKV + I_O + 2 * I_PP + 2 * I_PG;
    constexpr int N_ITEMS = N_SMALL + 3 * 128 * I_ME;
#define TR_DECODE(IT, JOB) do { int r = (IT); const float* src; int N; const float* gain = nullptr; bf16_t* dst; int Kd; int f8 = 0; \
        if (r < I_IN) { const int kb = r / 128, nb = r % 128; src = KF(A_W_IN) + (size_t)kb * 64 * 4096 + nb * 32; N = 4096; gain = KF(A_NORM_MIX) + kb * 64; if (MK_F8_PROJ) { dst = (bf16_t*)(ws + WS_W_IN + (size_t)nb * 32 * 2048 + kb * 64); f8 = 1; } else dst = (bf16_t*)(ws + WS_W_IN) + (size_t)nb * 32 * 2048 + kb * 64; Kd = 2048; } \
        else if ((r -= I_IN) < 2 * I_G) { const int ig = r / I_G; r %= I_G; const int blk = r / 32, kb = (r % 32) / 8, nb = r % 8; const int n0 = nb * 32; \
            src = (ig ? KF(A_W_IG) : KF(A_W_RG)) + (size_t)blk * 65536 + (size_t)kb * 64 * 256 + n0; N = 256; \
            const int drow = blk * 512 + (n0 >> 7) * 256 + ig * 128 + (n0 & 127); \
            dst = (bf16_t*)(ws + WS_W_G) + (size_t)drow * 256 + kb * 64; Kd = 256; } \
        else if ((r -= 2 * I_G) < I_OUT) { const int kb = r / 64, nb = r % 64; src = KF(A_W_OUT) + (size_t)kb * 64 * 2048 + nb * 32; N = 2048; if (MK_F8_WOUT) { dst = (bf16_t*)(ws + WS_W_OUT + (size_t)nb * 32 * 2048 + kb * 64); f8 = 1; } else dst = (bf16_t*)(ws + WS_W_OUT) + (size_t)nb * 32 * 2048 + kb * 64; Kd = 2048; } \
        else if ((r -= I_OUT) < I_QKV) { const int kb = r / 288, nb = r % 288; src = KF(A_W_QKV) + (size_t)kb * 64 * NQKV + nb * 32; N = NQKV; gain = KF(A_NORM_MIX) + DM + kb * 64; dst = (bf16_t*)(ws + WS_W_QKV + (size_t)nb * 32 * 2048 + kb * 64); Kd = 2048; f8 = 1; } \
        else if ((r -= I_QKV) < I_O) { const int kb = r / 64, nb = r % 64; src = KF(A_W_O) + (size_t)kb * 64 * 2048 + nb * 32; N = 2048; if (MK_F8_WO) { dst = (bf16_t*)(ws + WS_W_O + (size_t)nb * 32 * 1024 + kb * 64); f8 = 1; } else dst = (bf16_t*)(ws + WS_W_O) + (size_t)nb * 32 * 1024 + kb * 64; Kd = 1024; } \
        else if ((r -= I_O) < 2 * I_PP) { const int l = r / I_PP; r %= I_PP; const int kb = r / 64, nb = r % 64; \
            src = KF(A_PLE_PROJ) + (size_t)l * 256 * 2048 + (size_t)kb * 64 * 2048 + nb * 32; N = 2048; dst = (bf16_t*)(ws + WS_W_PP + (size_t)l * MiB) + (size_t)nb * 32 * 256 + kb * 64; Kd = 256; } \
        else if ((r -= 2 * I_PP) < 2 * I_PG) { const int l = r / I_PG; r %= I_PG; const int kb = r / 64, nb = r % 64; \
            src = KF(A_PLE_GATE) + (size_t)l * 2048 * 2048 + (size_t)kb * 64 * 2048 + nb * 32; N = 2048; if (MK_F8_PLEG) { dst = (bf16_t*)(ws + WS_W_PG + (size_t)l * 8 * MiB + (size_t)nb * 32 * 2048 + kb * 64); f8 = 1; } else dst = (bf16_t*)(ws + WS_W_PG + (size_t)l * 8 * MiB) + (size_t)nb * 32 * 2048 + kb * 64; Kd = 2048; } \
        else { r -= 2 * I_PG; const int mat = r / (128 * I_ME); r %= (128 * I_ME); const int le = r / I_ME, l = le >> 6, e = le & 63; r %= I_ME; \
          if (mat < 2) { \
              const int kb = r / 16, nb = r % 16, n0 = nb * 32; \
              src = (mat ? KF(A_W_UP) : KF(A_W_GATE)) + (size_t)le * 2048 * 512 + (size_t)kb * 64 * 512 + n0; N = 512; gain = KF(A_NORM_FFN) + l * DM + kb * 64; \
              const int drow = e * 1024 + (n0 >> 7) * 256 + mat * 128 + (n0 & 127); \
              dst = (bf16_t*)(ws + WS_W_GU + (size_t)l * 256 * MiB + (size_t)drow * 2048 + kb * 64); Kd = 2048; f8 = 1; \
          } else { \
              const int kb = r / 64, nb = r % 64; \
              src = KF(A_W_DOWN) + (size_t)le * 512 * 2048 + (size_t)kb * 64 * 2048 + nb * 32; N = 2048; dst = (bf16_t*)(ws + WS_W_D + (size_t)l * 128 * MiB + (size_t)(e * 2048 + nb * 32) * 512 + kb * 64); Kd = 512; f8 = 1; \
          } } \
        (JOB).src = src; (JOB).gain = gain; (JOB).dst = dst; (JOB).N = N; (JOB).Kd = Kd; (JOB).f8 = f8; } while (0)
    { int it = gw;
      if (it < N_ITEMS) {
        TrJob cur; TR_DECODE(it, cur);
        float v[32]; tr_load(v, cur, F.lane);
        for (;;) {
            const int nit = it + NGW; const bool hn = nit < N_ITEMS;
            TrJob nx = cur; float vn[32];
            if (hn) { TR_DECODE(nit, nx); tr_load(vn, nx, F.lane); }
            tr_store(v, cur, scr, F.lane);
            if (!hn) break;
            cur = nx; it = nit;
#pragma unroll
            for (int i = 0; i < 32; ++i) v[i] = vn[i];
        }
      } }
#undef TR_DECODE
    { const float* xin = KF(A_X);
    for (int row = gw; row < T; row += NGW) {
        const float* xr = xin + (size_t)row * DM + 8 * F.lane; bf16_t* ob = (bf16_t*)(ws + WS_HB) + (size_t)row * DM + 8 * F.lane;
        f32x4 v[8]; float ss = 0.f;
#pragma unroll
        for (int j = 0; j < 4; ++j) { v[2 * j] = *(const f32x4*)(xr + 512 * j); v[2 * j + 1] = *(const f32x4*)(xr + 512 * j + 4); }
#pragma unroll
        for (int j = 0; j < 8; ++j) ss += (v[j][0] * v[j][0] + v[j][1] * v[j][1]) + (v[j][2] * v[j][2] + v[j][3] * v[j][3]);
#pragma unroll
        for (int j = 0; j < 4; ++j) *(u32x4*)(ob + 512 * j) = pack8(v[2 * j], v[2 * j + 1]);
        if (MK_F8_PROJ) {
#pragma unroll
            for (int j = 0; j < 4; ++j) { u32x2 q; q.x = pk4_fp8(v[2 * j][0], v[2 * j][1], v[2 * j][2], v[2 * j][3]); q.y = pk4_fp8(v[2 * j + 1][0], v[2 * j + 1][1], v[2 * j + 1][2], v[2 * j + 1][3]); *(u32x2*)(ws + WS_H8 + (size_t)row * DM + 512 * j + 8 * F.lane) = q; } }
        ss = wave_sum(ss);
        if (F.lane == 0) ((rs_t*)(ws + WS_RSX))[row] = rs_fix(ss);
    } }
    { const float* pin = KF(A_P);
    for (int i = gt; i < 2 * T * PLE / 8; i += NGT) {
        const f32x4 a = *(const f32x4*)(pin + (size_t)i * 8), b = *(const f32x4*)(pin + (size_t)i * 8 + 4);
        *(u32x4*)((bf16_t*)(ws + WS_PB) + (size_t)i * 8) = pack8(a, b);
    } }
    for (int i = gt; i < DM; i += NGT) { const float l = KF(A_LAM)[i]; const float ls = fminf(l, 0.f) - log1pf(__expf(-fabsf(l))); ((float*)(ws + WS_CLAM))[i] = 8.0f * ls; }
    for (int i = gt; i < 2 * 256 * DM; i += NGT) {
        const int l = i / (256 * DM), rem = i % (256 * DM), n = rem / DM, k = rem % DM;
        float v = 0.f;
        if (n < 8) v = KF(A_W_GROUP)[(size_t)l * DM * 8 + (size_t)k * 8 + n];
        else if (n < 72) { const int g = (n - 8) >> 3, e = (n - 8) & 7; v = KF(A_W_EXPERT)[(size_t)l * 8 * DM * 8 + (size_t)g * DM * 8 + (size_t)k * 8 + e]; }
        v *= KF(A_NORM_FFN)[l * DM + k];
        ((bf16_t*)(ws + WS_W_R))[i] = (bf16_t)(cvt_pk_bf16(v, 0.f) & 0xffffu);
    }
}

DI void conv_phase(const Ctx& F, const bf16_t* proj, const float* cw, const float* cb, bf16_t* xc) {
    const int cg = F.tid & 255, sub = F.tid >> 8, ch = cg * 8;
    float w[4][8], b[8];
#pragma unroll
    for (int k = 0; k < 4; ++k)
#pragma unroll
        for (int j = 0; j < 8; ++j) w[k][j] = cw[k * DM + ch + j];
#pragma unroll
    for (int j = 0; j < 8; ++j) b[j] = cb[ch + j];
    for (int item = F.bid; item < T / 64; item += F.G) {
        const int t0 = item * 64 + sub * 32, s0 = t0 & (SEQ - 1);
        float x0[8], x1[8], x2[8];
#pragma unroll
        for (int j = 0; j < 8; ++j) { x0[j] = 0.f; x1[j] = 0.f; x2[j] = 0.f; }
        if (s0 >= 3) { unpack8(*(const u32x4*)(proj + (size_t)(t0 - 3) * 4096 + DM + ch), x0); unpack8(*(const u32x4*)(proj + (size_t)(t0 - 2) * 4096 + DM + ch), x1); unpack8(*(const u32x4*)(proj + (size_t)(t0 - 1) * 4096 + DM + ch), x2); }
#pragma unroll 8
        for (int i = 0; i < 32; ++i) {
            float x3[8]; unpack8(*(const u32x4*)(proj + (size_t)(t0 + i) * 4096 + DM + ch), x3);
            float y[8];
#pragma unroll
            for (int j = 0; j < 8; ++j) { y[j] = b[j] + w[0][j] * x0[j] + w[1][j] * x1[j] + w[2][j] * x2[j] + w[3][j] * x3[j]; x0[j] = x1[j]; x1[j] = x2[j]; x2[j] = x3[j]; }
            *(u32x4*)(xc + (size_t)(t0 + i) * DM + ch) = pack8((f32x4){y[0], y[1], y[2], y[3]}, (f32x4){y[4], y[5], y[6], y[7]});
        }
    }
}

DI void scanA_phase(const Ctx& F, const bf16_t* LA, const bf16_t* U, float* SP, float* SH) {
    const int ch = F.tid * 4;
    for (int item = F.bid; item < T / 128; item += F.G) {
        const size_t base = (size_t)item * 128 * DM + ch;
        float sl[4] = {0.f, 0.f, 0.f, 0.f}, h[4] = {0.f, 0.f, 0.f, 0.f};
#pragma unroll 8
        for (int i = 0; i < 128; ++i) {
            const u32x2 lw = *(const u32x2*)(LA + base + (size_t)i * DM), uw = *(const u32x2*)(U + base + (size_t)i * DM);
            const float l[4] = {bflo(lw.x), bfhi(lw.x), bflo(lw.y), bfhi(lw.y)}, uu[4] = {bflo(uw.x), bfhi(uw.x), bflo(uw.y), bfhi(uw.y)};
#pragma unroll
            for (int j = 0; j < 4; ++j) { sl[j] += l[j]; h[j] = __expf(l[j]) * h[j] + uu[j]; }
        }
        *(f32x4*)(SP + (size_t)item * DM + ch) = (f32x4){sl[0], sl[1], sl[2], sl[3]};
        *(f32x4*)(SH + (size_t)item * DM + ch) = (f32x4){h[0], h[1], h[2], h[3]};
    }
}
DI void scanB_phase(const Ctx& F, const float* SP, const float* SH, float* CIN) {
    const int gw = F.bid * 8 + F.wave, NGW = F.G * 8;
    for (int job = gw; job < NB * DM; job += NGW) {
        const int b = job / DM, ch = job % DM;
        const size_t i0 = ((size_t)(b * 128 + 2 * F.lane)) * DM + ch, i1 = i0 + DM;
        const float Pa = __expf(SP[i0]), Ha = SH[i0], Pb = __expf(SP[i1]), Hb = SH[i1];
        float Pc = Pa * Pb, Hc = Pb * Ha + Hb;
#pragma unroll
        for (int off = 1; off < 64; off <<= 1) {
            const float Pp = __shfl_up(Pc, off), Hp = __shfl_up(Hc, off);
            if (F.lane >= off) { Hc = Pc * Hp + Hc; Pc = Pc * Pp; }
        }
        float ex = __shfl_up(Hc, 1); if (F.lane == 0) ex = 0.f;
        CIN[i0] = ex; CIN[i1] = Pa * ex + Ha;
    }
}
DI float gelu_tanh(float x) { const float z = 0.7978845608028654f * (x + 0.044715f * x * x * x); const float e = __expf(2.0f * z); const float th = 1.0f - 2.0f / (e + 1.0f); return 0.5f * x * (1.0f + th); }
template <bool F8> DI void scanC_phase(const Ctx& F, const bf16_t* LA, const bf16_t* U, const bf16_t* proj, const float* CIN, bf16_t* Y) {
    const int ch = F.tid * 4;
    for (int item = F.bid; item < T / 128; item += F.G) {
        const size_t base = (size_t)item * 128 * DM + ch;
        const f32x4 c = *(const f32x4*)(CIN + (size_t)item * DM + ch);
        float h[4] = {c[0], c[1], c[2], c[3]};
#pragma unroll 8
        for (int i = 0; i < 128; ++i) {
            const u32x2 lw = *(const u32x2*)(LA + base + (size_t)i * DM), uw = *(const u32x2*)(U + base + (size_t)i * DM);
            const u32x2 gw = *(const u32x2*)(proj + ((size_t)item * 128 + i) * 4096 + ch);
            const float l[4] = {bflo(lw.x), bfhi(lw.x), bflo(lw.y), bfhi(lw.y)}, uu[4] = {bflo(uw.x), bfhi(uw.x), bflo(uw.y), bfhi(uw.y)}, gg[4] = {bflo(gw.x), bfhi(gw.x), bflo(gw.y), bfhi(gw.y)};
            float y[4];
#pragma unroll
            for (int j = 0; j < 4; ++j) { h[j] = __expf(l[j]) * h[j] + uu[j]; y[j] = gelu_tanh(gg[j]) * h[j]; }
            if constexpr (F8) *(unsigned*)((unsigned char*)Y + base + (size_t)i * DM) = pk4_fp8(y[0] * 8.f, y[1] * 8.f, y[2] * 8.f, y[3] * 8.f);
            else { u32x2 o; o.x = cvt_pk_bf16(y[0], y[1]); o.y = cvt_pk_bf16(y[2], y[3]); *(u32x2*)(Y + base + (size_t)i * DM) = o; }
        }
    }
}

DI void route_phase(const Ctx& F, const float* logits, const float* b_group, const float* b_expert, unsigned* gcount, int* slot_aid, float* slot_gate) {
    LAS unsigned* hist = (LAS unsigned*)(F.lds + MISC_OFF + MO_HIST); LAS unsigned* base = hist + 64;
    for (int blk = F.bid; blk < T / 128; blk += F.G) {
        if (F.tid < 64) hist[F.tid] = 0u;
        __syncthreads();
        const int t = blk * 128 + F.tid;
        int e0 = 0, e1 = 0; float g0 = 0.f, g1 = 0.f; unsigned r0 = 0u, r1 = 0u;
        if (F.tid < 128) {
            const float* lp = logits + (size_t)t * 128;
            const f32x4 a = *(const f32x4*)lp, b = *(const f32x4*)(lp + 4);
            float lg[8] = {a[0], a[1], a[2], a[3], b[0], b[1], b[2], b[3]};
            int gi = 0; float gm = -3.0e38f;
#pragma unroll
            for (int j = 0; j < 8; ++j) { lg[j] += b_group[j]; if (lg[j] > gm) { gm = lg[j]; gi = j; } }
            float den = 0.f;
#pragma unroll
            for (int j = 0; j < 8; ++j) den += __expf(lg[j] - gm);
            const float ptop = 1.0f / den;
            const f32x4 c = *(const f32x4*)(lp + 8 + gi * 8), d = *(const f32x4*)(lp + 12 + gi * 8);
            float le[8] = {c[0], c[1], c[2], c[3], d[0], d[1], d[2], d[3]};
            int i1 = 0; float v1 = -3.0e38f;
#pragma unroll
            for (int j = 0; j < 8; ++j) { le[j] += b_expert[gi * 8 + j]; if (le[j] > v1) { v1 = le[j]; i1 = j; } }
            int i2 = 0; float v2 = -3.0e38f;
#pragma unroll
            for (int j = 0; j < 8; ++j) { if (j != i1 && le[j] > v2) { v2 = le[j]; i2 = j; } }
            const float w1 = 1.0f / (1.0f + __expf(v2 - v1)), w2 = 1.0f - w1;
            e0 = gi * 8 + i1; e1 = gi * 8 + i2; g0 = ptop * w1; g1 = ptop * w2;
            r0 = __hip_atomic_fetch_add(hist + e0, 1u, __ATOMIC_RELAXED, __HIP_MEMORY_SCOPE_WORKGROUP);
            r1 = __hip_atomic_fetch_add(hist + e1, 1u, __ATOMIC_RELAXED, __HIP_MEMORY_SCOPE_WORKGROUP);
        }
        __syncthreads();
        if (F.tid < 64) { const unsigned c = hist[F.tid]; base[F.tid] = c ? __hip_atomic_fetch_add(gcount + F.tid, c, __ATOMIC_RELAXED, __HIP_MEMORY_SCOPE_AGENT) : 0u; }
        __syncthreads();
        if (F.tid < 128) {
            const unsigned p0 = base[e0] + r0, p1 = base[e1] + r1;
            slot_aid[e0 * SLOTCAP + p0] = 2 * t; slot_gate[e0 * SLOTCAP + p0] = g0;
            slot_aid[e1 * SLOTCAP + p1] = 2 * t + 1; slot_gate[e1 * SLOTCAP + p1] = g1;
        }
        __syncthreads();
    }
}
DI void moe_tables(const Ctx& F, unsigned* gcount) {
    LAS int* cnt = (LAS int*)(F.lds + MISC_OFF + MO_CNT); LAS int* mtpre = (LAS int*)(F.lds + MISC_OFF + MO_MTPRE); LAS unsigned char* t2e = F.lds + MISC_OFF + MO_T2E;
    if (F.tid < 64) cnt[F.tid] = (int)__hip_atomic_load(gcount + F.tid, __ATOMIC_RELAXED, __HIP_MEMORY_SCOPE_AGENT);
    __syncthreads();
    if (F.tid == 0) { int s = 0; for (int e = 0; e < 64; ++e) { mtpre[e] = s; s += (cnt[e] + 255) >> 8; } mtpre[64] = s; }
    __syncthreads();
    if (F.tid < 64) { const int a = mtpre[F.tid], b = mtpre[F.tid + 1]; for (int m = a; m < b && m < 384; ++m) t2e[m] = (unsigned char)F.tid; }
    __syncthreads();
}

template <bool F8> DI void combine_phase(const Ctx& F, const unsigned char* yb, bf16_t* hb, unsigned char* h8) {
    const int gw = F.bid * 8 + F.wave, NGW = F.G * 8;
    for (int row = gw; row < T; row += NGW) {
        const unsigned char* y0 = yb + (size_t)(2 * row) * DM + 8 * F.lane; const unsigned char* y1 = y0 + DM; bf16_t* hrow = hb + (size_t)row * DM + 8 * F.lane;
        u32x4 hw[4]; u32x2 a0[4], a1[4];
#pragma unroll
        for (int j = 0; j < 4; ++j) { hw[j] = *(const u32x4*)(hrow + 512 * j); a0[j] = *(const u32x2*)(y0 + 512 * j); a1[j] = *(const u32x2*)(y1 + 512 * j); }
#pragma unroll
        for (int j = 0; j < 4; ++j) {
            float h[8], v0[8], v1[8]; unpack8(hw[j], h); unpack8_fp8(a0[j], v0); unpack8_fp8(a1[j], v1);
#pragma unroll
            for (int k = 0; k < 8; ++k) h[k] += (v0[k] + v1[k]) * (1.0f / 16.0f);
            *(u32x4*)(hrow + 512 * j) = pack8((f32x4){h[0], h[1], h[2], h[3]}, (f32x4){h[4], h[5], h[6], h[7]});
            if constexpr (F8) { u32x2 q; q.x = pk4_fp8(h[0], h[1], h[2], h[3]); q.y = pk4_fp8(h[4], h[5], h[6], h[7]); *(u32x2*)(h8 + (size_t)row * DM + 512 * j + 8 * F.lane) = q; }
        }
    }
}
DI void finish_phase(const Ctx& F, float* out, const bf16_t* eg, const rs_t* rowss_eg, const float* gain, bf16_t* hb, unsigned char* h8, rs_t* rowss_next, bool last) {
    const int gw = F.bid * 8 + F.wave, NGW = F.G * 8;
    float gn[4][8];
#pragma unroll
    for (int j = 0; j < 4; ++j)
#pragma unroll
        for (int k = 0; k < 8; ++k) gn[j][k] = gain[512 * j + 8 * F.lane + k];
    for (int row = gw; row < T; row += NGW) {
        float* orow = out + (size_t)row * DM + 8 * F.lane; const bf16_t* erow = eg + (size_t)row * DM + 8 * F.lane; bf16_t* hrow = hb + (size_t)row * DM + 8 * F.lane;
        u32x4 hw[4], ew[4];
#pragma unroll
        for (int j = 0; j < 4; ++j) { hw[j] = *(const u32x4*)(hrow + 512 * j); ew[j] = *(const u32x4*)(erow + 512 * j); }
        const float rs = rs_rstd(rowss_eg[row]);
        float ss = 0.f;
#pragma unroll
        for (int j = 0; j < 4; ++j) {
            float h[8], ev[8]; unpack8(hw[j], h); unpack8(ew[j], ev);
#pragma unroll
            for (int k = 0; k < 8; ++k) { h[k] += ev[k] * rs * gn[j][k]; ss += h[k] * h[k]; }
            if (last) { *(f32x4*)(orow + 512 * j) = (f32x4){h[0], h[1], h[2], h[3]}; *(f32x4*)(orow + 512 * j + 4) = (f32x4){h[4], h[5], h[6], h[7]}; }
            else { *(u32x4*)(hrow + 512 * j) = pack8((f32x4){h[0], h[1], h[2], h[3]}, (f32x4){h[4], h[5], h[6], h[7]});
                   u32x2 q; q.x = pk4_fp8(h[0], h[1], h[2], h[3]); q.y = pk4_fp8(h[4], h[5], h[6], h[7]); *(u32x2*)(h8 + (size_t)row * DM + 512 * j + 8 * F.lane) = q; }
        }
        if (!last) { ss = wave_sum(ss); if (F.lane == 0) rowss_next[row] = rs_fix(ss); }
    }
}

DI int k_off(int row, int chunk) { return row * 256 + ((chunk ^ (row & 15)) << 4); }
DI int v_off(int row, int chunk) { return row * 256 + ((chunk ^ ((row & 7) << 1)) << 4); }
struct AUnit { int g, head, d, n; size_t tok0, prow0; };
DI void attn_decode_seg(int sid, int u, AUnit& U) {
    const int g = sid >> 8, idx = sid & 255, head = idx & 7, rest = idx >> 3;
    const int dsh = 2 * g, nsc = 16 >> dsh, chain = rest / nsc, b = chain >> dsh, r = chain & ((1 << dsh) - 1);
    U.g = g; U.head = head; U.d = 1 << dsh; U.n = (rest % nsc) * 8 + u; U.tok0 = (size_t)b * SEQ + r;
    U.prow0 = (size_t)b * SEQ + (size_t)r * (SEQ >> dsh);
}
#define ATT_PLANE(U_, s_) (qkv + (((size_t)((U_).g * 3 + (s_)) * 8 + (U_).head) * T) * HD)
#define ATT_LOADS(U_, first_) do { \
    _Pragma("unroll") for (int ps = 0; ps < 8; ++ps) { if ((first_) || ps >= 4) { const int j_ = 128 * ((U_).n - 1) + ps * 32 + rowi; kraw[ps] = (u32x2){0u, 0u}; vraw[ps] = (u32x2){0u, 0u}; kpos[ps] = 0; \
        if (j_ >= 0) { const size_t ro_ = ((U_).prow0 + (size_t)j_) * HD + chunk * 8; kraw[ps] = *(const u32x2*)(ATT_PLANE(U_, 1) + ro_); vraw[ps] = *(const u32x2*)(ATT_PLANE(U_, 2) + ro_); \
                       kpos[ps] = positions[(U_).tok0 + (size_t)j_ * (U_).d]; } } } \
    { const int jq_ = 128 * (U_).n + 16 * w + q16; \
      _Pragma("unroll") for (int dk = 0; dk < 4; ++dk) qraw[dk] = *(const u32x2*)(ATT_PLANE(U_, 0) + ((U_).prow0 + (size_t)jq_) * HD + dk * 32 + 8 * gq); \
      qpos = positions[(U_).tok0 + (size_t)jq_ * (U_).d]; } \
    } while (0)
DI float rope_rev_const(int i) { return __builtin_amdgcn_exp2f(-(float)i * 0.20762050593046014f) * 0.15915494309189535f; }
DI void attn_phase(const Ctx& F, const unsigned char* qkv, const float* q_gain, const float* k_gain, const int* positions, bf16_t* og, float* lse) {
    LAS unsigned char* Ks = F.lds; LAS unsigned char* Vs = F.lds + 65536;
    const int lane = F.lane, w = F.wave, q16 = lane & 15, gq = lane >> 4;
    const int chunk = F.tid & 15, rowi = F.tid >> 4, ci = 8 * (chunk & 7);
    const int nseg = (768 - F.bid + F.G - 1) / F.G, nsteps = nseg * 8;
    if (F.bid >= 768) return;
    int st = 0;
    AUnit U, Un; attn_decode_seg(F.bid, 0, U);
    u32x2 kraw[8], vraw[8], qraw[4]; int kpos[8], qpos;
#pragma unroll
    for (int ps = 0; ps < 8; ++ps) { kraw[ps] = (u32x2){0u, 0u}; vraw[ps] = (u32x2){0u, 0u}; kpos[ps] = 0; }
    ATT_LOADS(U, true);
    for (;;) {
        const int g = U.g, head = U.head, n = U.n;
        const bool first = (st & 7) == 0;
        {
            float kg[8]; { const f32x4 a = *(const f32x4*)(k_gain + g * HD + 8 * chunk), c = *(const f32x4*)(k_gain + g * HD + 8 * chunk + 4);
#pragma unroll
                for (int k = 0; k < 4; ++k) { kg[k] = a[k]; kg[4 + k] = c[k]; } }
            float kc[8];
#pragma unroll
            for (int k = 0; k < 8; ++k) kc[k] = rope_rev_const(ci + k);
#pragma unroll
            for (int ps = 0; ps < 8; ++ps) {
                if (first || ps >= 4) {
                    const int krow = ps * 32 + rowi;
                    if (!first) {
                        const u32x4 tk = *(const LAS u32x4*)(Ks + k_off(krow, chunk)), tv = *(const LAS u32x4*)(Vs + v_off(krow, chunk));
                        *(LAS u32x4*)(Ks + k_off(krow - 128, chunk)) = tk; *(LAS u32x4*)(Vs + v_off(krow - 128, chunk)) = tv; }
                    float v[8]; unpack8_fp8(kraw[ps], v);
                    float ss = 0.f;
#pragma unroll
                    for (int k = 0; k < 8; ++k) ss += v[k] * v[k];
                    ss = row16_sum(ss);
                    const float rs = __builtin_amdgcn_rsqf(ss * (1.0f / HD) + EPS);
                    float pv[8], o[8];
#pragma unroll
                    for (int k = 0; k < 8; ++k) v[k] = v[k] * rs * kg[k];
#pragma unroll
                    for (int k = 0; k < 8; ++k) pv[k] = row16_xor8(v[k]);
                    const float fp = (float)kpos[ps];
#pragma unroll
                    for (int k = 0; k < 8; ++k) { const float rev = fp * kc[k], fr = rev - __builtin_rintf(rev); const float c = __builtin_amdgcn_cosf(fr), sn = __builtin_amdgcn_sinf(fr);
                        o[k] = (chunk < 8) ? (v[k] * c - pv[k] * sn) : (v[k] * c + pv[k] * sn); }
                    *(LAS u32x4*)(Ks + k_off(krow, chunk)) = pack8((f32x4){o[0], o[1], o[2], o[3]}, (f32x4){o[4], o[5], o[6], o[7]});
                    float vv[8]; unpack8_fp8(vraw[ps], vv);
                    *(LAS u32x4*)(Vs + v_off(krow, chunk)) = pack8((f32x4){vv[0], vv[1], vv[2], vv[3]}, (f32x4){vv[4], vv[5], vv[6], vv[7]});
                }
            }
        }
        const size_t pq = U.prow0 + (size_t)(128 * n + 16 * w + q16);
        bf16x8 qf[4];
        {
            float qv[4][8];
#pragma unroll
            for (int dk = 0; dk < 4; ++dk) unpack8_fp8(qraw[dk], qv[dk]);
            float ss = 0.f;
#pragma unroll
            for (int dk = 0; dk < 4; ++dk)
#pragma unroll
                for (int k = 0; k < 8; ++k) ss += qv[dk][k] * qv[dk][k];
            ss += __shfl_xor(ss, 16); ss += __shfl_xor(ss, 32);
            const float rs = __builtin_amdgcn_rsqf(ss * (1.0f / HD) + EPS);
#pragma unroll
            for (int dk = 0; dk < 4; ++dk) { const f32x4 ga = *(const f32x4*)(q_gain + g * HD + dk * 32 + 8 * gq), gb = *(const f32x4*)(q_gain + g * HD + dk * 32 + 8 * gq + 4);
#pragma unroll
                for (int k = 0; k < 4; ++k) { qv[dk][k] *= rs * ga[k]; qv[dk][4 + k] *= rs * gb[k]; } }
#pragma unroll
            for (int dk = 0; dk < 2; ++dk) {
                const float fp = (float)qpos;
#pragma unroll
                for (int k = 0; k < 8; ++k) { const float rev = fp * rope_rev_const(32 * dk + 8 * gq + k), fr = rev - __builtin_rintf(rev); const float c = __builtin_amdgcn_cosf(fr), sn = __builtin_amdgcn_sinf(fr);
                    const float t1 = qv[dk][k], t2 = qv[dk + 2][k]; qv[dk][k] = t1 * c - t2 * sn; qv[dk + 2][k] = t2 * c + t1 * sn; }
            }
#pragma unroll
            for (int dk = 0; dk < 4; ++dk) qf[dk] = __builtin_bit_cast(bf16x8, pack8((f32x4){qv[dk][0], qv[dk][1], qv[dk][2], qv[dk][3]}, (f32x4){qv[dk][4], qv[dk][5], qv[dk][6], qv[dk][7]}));
        }
        asm volatile("" : "+v"(qf[0]), "+v"(qf[1]), "+v"(qf[2]), "+v"(qf[3]) :: "memory");
        __syncthreads();
        const int nst = st + 1; const bool hn = nst < nsteps;
        if (hn) { attn_decode_seg(F.bid + (nst >> 3) * F.G, nst & 7, Un); const bool nfirst = (nst & 7) == 0; ATT_LOADS(Un, nfirst); }
        __builtin_amdgcn_sched_barrier(0);
        f32x4 s[9];
#pragma unroll
        for (int i = 0; i < 9; ++i) {
            f32x4 a = {0.f, 0.f, 0.f, 0.f};
            const int krow = 16 * (w + i) + q16;
#pragma unroll
            for (int dk = 0; dk < 4; ++dk) { const bf16x8 kf = *(const LAS bf16x8*)(Ks + k_off(krow, 4 * dk + gq)); a = __builtin_amdgcn_mfma_f32_16x16x32_bf16(kf, qf[dk], a, 0, 0, 0); }
            s[i] = a;
        }
        constexpr float C2 = 0.08838834764831845f * 1.4426950408889634f;
        float mx = -3.0e38f;
#pragma unroll
        for (int i = 0; i < 9; ++i)
#pragma unroll
            for (int rg = 0; rg < 4; ++rg) {
                const int dlt = 16 * i + 4 * gq + rg - q16;
                bool ok = (dlt >= 0) && (dlt <= 128);
                if (n == 0 && (w + i) < 8) ok = false;
                const float v = ok ? s[i][rg] * C2 : -1.0e30f;
                s[i][rg] = v; mx = fmaxf(mx, v);
            }
        mx = fmaxf(mx, __shfl_xor(mx, 16)); mx = fmaxf(mx, __shfl_xor(mx, 32));
        float den = 0.f;
#pragma unroll
        for (int i = 0; i < 9; ++i)
#pragma unroll
            for (int rg = 0; rg < 4; ++rg) { const float p = __builtin_amdgcn_exp2f(s[i][rg] - mx); s[i][rg] = p; den += p; }
        den += __shfl_xor(den, 16); den += __shfl_xor(den, 32);
        f32x4 o[8];
#pragma unroll
        for (int db = 0; db < 8; ++db) o[db] = (f32x4){0.f, 0.f, 0.f, 0.f};
#pragma unroll
        for (int t5 = 0; t5 < 5; ++t5) {
            const int i0 = 2 * t5, i1 = (t5 < 4) ? 2 * t5 + 1 : 8;
            const f32x4 p0 = s[i0], p1 = (t5 < 4) ? s[i1] : (f32x4){0.f, 0.f, 0.f, 0.f};
            const u32x4 pw = pack8(p0, p1); const bf16x8 pb = __builtin_bit_cast(bf16x8, pw);
            const int row0 = 16 * (w + i0) + 4 * gq + (q16 >> 2), row1 = 16 * (w + i1) + 4 * gq + (q16 >> 2);
#pragma unroll
            for (int db = 0; db < 8; ++db) {
                const int vch = 2 * db + ((q16 & 3) >> 1), sub8 = (q16 & 1) * 8;
                const s16x4 lo = __builtin_amdgcn_ds_read_tr16_b64_v4i16((LAS s16x4*)(Vs + v_off(row0, vch) + sub8));
                const s16x4 hi = __builtin_amdgcn_ds_read_tr16_b64_v4i16((LAS s16x4*)(Vs + v_off(row1, vch) + sub8));
                const bf16x8 vf = __builtin_shufflevector(lo, hi, 0, 1, 2, 3, 4, 5, 6, 7);
                o[db] = __builtin_amdgcn_mfma_f32_16x16x32_bf16(vf, pb, o[db], 0, 0, 0);
            }
        }
        const float inv = 1.0f / den;
        bf16_t* orow = og + (((size_t)g * NHEAD + head) * T + pq) * HD + 4 * gq;
#pragma unroll
        for (int db = 0; db < 8; ++db) { u32x2 ow; ow.x = cvt_pk_bf16(o[db][0] * inv, o[db][1] * inv); ow.y = cvt_pk_bf16(o[db][2] * inv, o[db][3] * inv); *(u32x2*)(orow + 16 * db) = ow; }
        if (gq == 0) lse[((size_t)g * NHEAD + head) * T + pq] = (mx + __builtin_amdgcn_logf(den)) * 0.6931471805599453f;
        __syncthreads();
        if (!hn) break;
        U = Un; st = nst;
    }
}
#undef ATT_LOADS
#undef ATT_PLANE
template <bool F8> DI void merge_phase(const Ctx& F, const bf16_t* og, const float* lse, bf16_t* ob) {
    const int gt = F.bid * 512 + F.tid, NGT = F.G * 512;
    for (int i = gt; i < T * 128; i += NGT) {
        const int t = i >> 7, c8 = i & 127, head = c8 >> 4;
        const size_t p0 = g8::qkv_plane_row(t, 0), p1 = g8::qkv_plane_row(t, 2), p2 = g8::qkv_plane_row(t, 4);
        const float l0 = lse[((size_t)0 * NHEAD + head) * T + p0], l1 = lse[((size_t)1 * NHEAD + head) * T + p1], l2 = lse[((size_t)2 * NHEAD + head) * T + p2];
        const float m = fmaxf(l0, fmaxf(l1, l2));
        float w0 = __expf(l0 - m), w1 = __expf(l1 - m), w2 = __expf(l2 - m); const float inv = 1.0f / (w0 + w1 + w2); w0 *= inv; w1 *= inv; w2 *= inv;
        float a[8], b[8], c[8];
        const int dd = (c8 & 15) * 8;
        unpack8(*(const u32x4*)(og + (((size_t)0 * NHEAD + head) * T + p0) * HD + dd), a); unpack8(*(const u32x4*)(og + (((size_t)1 * NHEAD + head) * T + p1) * HD + dd), b); unpack8(*(const u32x4*)(og + (((size_t)2 * NHEAD + head) * T + p2) * HD + dd), c);
        float o[8];
#pragma unroll
        for (int k = 0; k < 8; ++k) o[k] = w0 * a[k] + w1 * b[k] + w2 * c[k];
        if constexpr (F8) { u32x2 q; q.x = pk4_fp8(o[0] * 16.f, o[1] * 16.f, o[2] * 16.f, o[3] * 16.f); q.y = pk4_fp8(o[4] * 16.f, o[5] * 16.f, o[6] * 16.f, o[7] * 16.f); *(u32x2*)((unsigned char*)ob + (size_t)t * 1024 + c8 * 8) = q; }
        else *(u32x4*)(ob + (size_t)t * 1024 + c8 * 8) = pack8((f32x4){o[0], o[1], o[2], o[3]}, (f32x4){o[4], o[5], o[6], o[7]});
    }
}

struct Args { const void* in[28]; float* out; unsigned char* ws; int ph_lo, ph_hi; };

__global__ void __launch_bounds__(512, 2) mk_fwd(Args args) {
    extern __shared__ __attribute__((aligned(16))) unsigned char lds_raw[];
    Ctx F; F.lds = (LAS unsigned char*)lds_raw; F.G = gridDim.x; F.bid = blockIdx.x;
    int wave_s = __builtin_amdgcn_readfirstlane((int)threadIdx.x >> 6); asm volatile("" : "+s"(wave_s));
#define RF() do { int l_ = (int)__builtin_amdgcn_mbcnt_hi(~0u, __builtin_amdgcn_mbcnt_lo(~0u, 0u)); asm volatile("" : "+v"(l_)); F.lane = l_; F.wave = wave_s; F.tid = wave_s * 64 + l_; } while (0)
    RF();
    unsigned char* ws = (unsigned char*)karg_ptr(A_WS);
    unsigned* ctl = (unsigned*)(ws + WS_CTL);
    for (int u = F.tid; u < (LDS_BYTES - MISC_OFF) / 4; u += 512) ((LAS unsigned*)(F.lds + MISC_OFF))[u] = 0u;
    __syncthreads();
    XcdBarrier bar; bar.bar = ctl + CW_BAR; bar.x = 0; bar.st = nullptr;
    if (N_LAUNCHES == 1) bar = xcd_barrier_post(ctl + CW_BAR, (volatile LAS unsigned*)(F.lds + MISC_OFF + MO_BARW), F.tid);
    const int lo = args.ph_lo, hi = args.ph_hi;
#define IN(k) (lo <= (k) && (k) < hi)
#define SEAM(k) do { if (IN((k) + 1)) { RF(); if (N_LAUNCHES == 1) xcd_barrier(bar, F.tid); } } while (0)

    bf16_t* HB = (bf16_t*)(ws + WS_HB);
    rs_t* rowss_acc = (rs_t*)(ctl + CW_ROWSS);
    rs_t* RSX = (rs_t*)(ws + WS_RSX); rs_t* RSH3 = (rs_t*)(ws + WS_RSH3);
    LAS unsigned char* ring = F.lds;

    if (IN(0)) { RF(); for (int rep = 0; rep < ((MK_DUP & 1) ? 2 : 1); ++rep) p0_prologue(F, ws); SEAM(0); }
    if (IN(1)) { RF();
        constexpr bool F8 = MK_F8_PROJ != 0; constexpr unsigned LD = F8 ? DM : DM * 2;
        g8::StaticSched S; S.init(F8 ? (const void*)(ws + WS_H8) : (const void*)HB, LD, ws + WS_W_IN, LD, T / 256, 4096 / 256, F.G, F.bid);
        g8::EpiBf16ScaleT<F8> E{(bf16_t*)(ws + WS_PROJ), 4096, RSX, F8 ? 1.0f / 64.0f : 1.0f};
        for (int rep = 0; rep < ((MK_DUP & 1024) ? 2 : 1); ++rep) g8::gemm_phase(ring, F.tid, F8 ? DM / 2 : DM, LD, LD, S, E);
        SEAM(1);
    }
    if (IN(2)) { RF(); for (int rep = 0; rep < ((MK_DUP & 512) ? 2 : 1); ++rep) conv_phase(F, (const bf16_t*)(ws + WS_PROJ), KF(A_CONV_W), KF(A_CONV_B), (bf16_t*)(ws + WS_XC)); SEAM(2); }
    if (IN(3)) { RF();
        g8::GateSched S; S.init(ws + WS_XC, ws + WS_W_G, F.G, F.bid);
        g8::EpiGates E{(const bf16_t*)(ws + WS_XC), KF(A_B_RG), KF(A_B_IG), (const float*)(ws + WS_CLAM), (bf16_t*)(ws + WS_LA), (bf16_t*)(ws + WS_U)};
        for (int rep = 0; rep < ((MK_DUP & 4096) ? 2 : 1); ++rep) g8::gemm_phase(ring, F.tid, 256, DM * 2, 256 * 2, S, E);
        SEAM(3);
    }
    if (IN(4)) { RF(); for (int rep = 0; rep < ((MK_DUP & 512) ? 2 : 1); ++rep) scanA_phase(F, (const bf16_t*)(ws + WS_LA), (const bf16_t*)(ws + WS_U), (float*)(ws + WS_SP), (float*)(ws + WS_SH)); SEAM(4); }
    if (IN(5)) { RF(); for (int rep = 0; rep < ((MK_DUP & 512) ? 2 : 1); ++rep) scanB_phase(F, (const float*)(ws + WS_SP), (const float*)(ws + WS_SH), (float*)(ws + WS_CIN)); SEAM(5); }
    if (IN(6)) { RF(); for (int rep = 0; rep < ((MK_DUP & 512) ? 2 : 1); ++rep) scanC_phase<MK_F8_WOUT != 0>(F, (const bf16_t*)(ws + WS_LA), (const bf16_t*)(ws + WS_U), (const bf16_t*)(ws + WS_PROJ), (const float*)(ws + WS_CIN), (bf16_t*)(ws + WS_XC)); SEAM(6); }
    if (IN(7)) { RF();
        constexpr bool F8 = MK_F8_WOUT != 0; constexpr unsigned LD = F8 ? DM : DM * 2;
        g8::StaticSched S; S.init(ws + WS_XC, LD, ws + WS_W_OUT, LD, T / 256, DM / 256, F.G, F.bid);
        g8::EpiResidT<F8> E{HB, ws + WS_H8, rowss_acc + 0 * T, F8 ? 1.0f / (64.0f * 8.0f) : 1.0f};
        g8::gemm_phase(ring, F.tid, F8 ? DM / 2 : DM, LD, LD, S, E); SEAM(7);
    }
#define MOE_LAYER(PH, L, RS_H, RS_EG, RS_NEXT, LAST) \
    if (IN(PH)) { RF();   \
        { g8::StaticSched S; S.init(HB, DM * 2, ws + WS_W_R + (size_t)(L) * MiB, DM * 2, T / 256, 1, F.G, F.bid); \
          g8::EpiLogits E{(float*)(ws + WS_LOGITS), RS_H}; g8::gemm_phase(ring, F.tid, DM, DM * 2, DM * 2, S, E); } \
        { g8::StaticSched S; S.init(ws + WS_PB + (size_t)(L) * T * PLE * 2, PLE * 2, ws + WS_W_PP + (size_t)(L) * MiB, PLE * 2, T / 256, DM / 256, F.G, F.bid); \
          g8::EpiBf16Scale E{(bf16_t*)(ws + WS_EG), DM, nullptr, 1.0f}; g8::gemm_phase(ring, F.tid, PLE, PLE * 2, PLE * 2, S, E); } \
        SEAM(PH); } \
    if (IN((PH) + 1)) { RF(); route_phase(F, (const float*)(ws + WS_LOGITS), KF(A_B_GROUP) + (L) * 8, KF(A_B_EXPERT) + (L) * 64, ctl + CW_CNT + (L) * 64, (int*)(ws + WS_SLOT_AID), (float*)(ws + WS_SLOT_GATE)); SEAM((PH) + 1); } \
    if (IN((PH) + 2)) { RF(); moe_tables(F, ctl + CW_CNT + (L) * 64); \
        g8::MoeSched<4, true> S; S.init(ws + WS_H8, DM, ws + WS_W_GU + (size_t)(L) * 256 * MiB, DM, (size_t)1024 * DM, (const int*)(ws + WS_SLOT_AID), F.lds + MISC_OFF, F.G, F.bid); \
        g8::EpiGU E{ws + WS_HID, (const int*)(ws + WS_SLOT_AID), RS_H}; for (int rep = 0; rep < ((MK_DUP & 8) ? 2 : 1); ++rep) g8::gemm_phase(ring, F.tid, DM / 2, DM, DM, S, E); SEAM((PH) + 2); } \
    if (IN((PH) + 3)) { RF(); moe_tables(F, ctl + CW_CNT + (L) * 64); \
        g8::MoeSched<8, false> S; S.init(ws + WS_HID, DEXP, ws + WS_W_D + (size_t)(L) * 128 * MiB, DEXP, (size_t)DM * DEXP, (const int*)(ws + WS_SLOT_AID), F.lds + MISC_OFF, F.G, F.bid); \
        g8::EpiDown E{ws + WS_YB, (const int*)(ws + WS_SLOT_AID), (const float*)(ws + WS_SLOT_GATE)}; for (int rep = 0; rep < ((MK_DUP & 16) ? 2 : 1); ++rep) g8::gemm_phase(ring, F.tid, DEXP / 2, DEXP, DEXP, S, E); SEAM((PH) + 3); } \
    if (IN((PH) + 4)) { RF(); combine_phase<MK_F8_PLEG != 0>(F, ws + WS_YB, HB, ws + WS_H8); SEAM((PH) + 4); } \
    if (IN((PH) + 5)) { RF(); constexpr bool F8 = MK_F8_PLEG != 0; constexpr unsigned LD = F8 ? DM : DM * 2; \
        g8::StaticSched S; S.init(F8 ? (const void*)(ws + WS_H8) : (const void*)HB, LD, ws + WS_W_PG + (size_t)(L) * 8 * MiB, LD, T / 256, DM / 256, F.G, F.bid); \
        g8::EpiPleGT<F8> E{(bf16_t*)(ws + WS_EG), RS_EG, F8 ? 1.0f / 64.0f : 1.0f}; g8::gemm_phase(ring, F.tid, F8 ? DM / 2 : DM, LD, LD, S, E); SEAM((PH) + 5); } \
    if (IN((PH) + 6)) { RF(); finish_phase(F, (float*)karg_ptr(A_OUT), (const bf16_t*)(ws + WS_EG), RS_EG, KF(A_PLE_NORM) + (L) * DM, HB, ws + WS_H8, RS_NEXT, LAST); SEAM((PH) + 6); }

    MOE_LAYER(8, 0, rowss_acc + 0 * T, rowss_acc + 1 * T, RSH3, false)
    if (IN(15)) { RF();
        g8::StaticSched S; S.init(ws + WS_H8, DM, ws + WS_W_QKV, DM, T / 256, NQKV / 256, F.G, F.bid);
        g8::EpiQkvPlanes E{ws + WS_QKV, RSH3, 1.0f / 64.0f};
        for (int rep = 0; rep < ((MK_DUP & 2) ? 2 : 1); ++rep) g8::gemm_phase(ring, F.tid, DM / 2, DM, DM, S, E);
        SEAM(15);
    }
    if (IN(17)) { RF(); for (int rep = 0; rep < ((MK_DUP & 4) ? 2 : 1); ++rep) attn_phase(F, ws + WS_QKV, KF(A_Q_GAIN), KF(A_K_GAIN), (const int*)karg_ptr(A_POS), (bf16_t*)(ws + WS_OG), (float*)(ws + WS_LSE)); SEAM(17); }
    if (IN(18)) { RF(); merge_phase<MK_F8_WO != 0>(F, (const bf16_t*)(ws + WS_OG), (const float*)(ws + WS_LSE), (bf16_t*)(ws + WS_OB)); SEAM(18); }
    if (IN(19)) { RF();
        constexpr bool F8 = MK_F8_WO != 0; constexpr unsigned LD = F8 ? 1024 : 2048;
        g8::StaticSched S; S.init(ws + WS_OB, LD, ws + WS_W_O, LD, T / 256, DM / 256, F.G, F.bid);
        g8::EpiResidT<F8> E{HB, ws + WS_H8, rowss_acc + 2 * T, F8 ? 1.0f / (64.0f * 16.0f) : 1.0f};
        g8::gemm_phase(ring, F.tid, F8 ? 512 : 1024, LD, LD, S, E); SEAM(19);
    }
    MOE_LAYER(20, 1, rowss_acc + 2 * T, rowss_acc + 3 * T, RSH3, true)
#undef IN
#undef SEAM
}

extern "C" void kernel_launch(void* const* d_in, const int* in_sizes, int n_in, void* d_out, int out_size, void* d_ws, size_t ws_size, hipStream_t stream) {
    static int grid = 0;
    if (grid == 0) {
        if (n_in != 28 || in_sizes[0] != T * DM || out_size != T * DM || ws_size < WS_END) {
            fprintf(stderr, "kernel_launch: unexpected problem (n_in %d, in0 %d, out %d, ws %zu < %zu); nothing launched\n", n_in, n_in > 0 ? in_sizes[0] : -1, out_size, ws_size, (size_t)WS_END); grid = -1; return; }
        int dev = 0, cus = 0, per_cu = 0;
        if (hipGetDevice(&dev) != hipSuccess || hipDeviceGetAttribute(&cus, hipDeviceAttributeMultiprocessorCount, dev) != hipSuccess) { grid = -1; return; }
        if (hipFuncSetAttribute((const void*)mk_fwd, hipFuncAttributeMaxDynamicSharedMemorySize, LDS_BYTES) != hipSuccess) { fprintf(stderr, "kernel_launch: hipFuncSetAttribute failed\n"); grid = -1; return; }
        if (hipOccupancyMaxActiveBlocksPerMultiprocessor(&per_cu, (const void*)mk_fwd, 512, LDS_BYTES) != hipSuccess || per_cu < 1)
            fprintf(stderr, "kernel_launch: note: occupancy query reports %d workgroups per CU\n", per_cu);
        (void)hipGetLastError();
        grid = cus;
    }
    if (grid < 0) return;
    if (hipMemsetAsync((char*)d_ws + WS_CTL, 0, CTL_ZERO_BYTES, stream) != hipSuccess) { fprintf(stderr, "kernel_launch: memset failed\n"); return; }
    Args a{};
    for (int i = 0; i < 28; ++i) a.in[i] = d_in[i];
    a.out = (float*)d_out; a.ws = (unsigned char*)d_ws;
    if (N_LAUNCHES == 1) {
        a.ph_lo = 0; a.ph_hi = NPH;
        hipLaunchKernelGGL(mk_fwd, dim3(grid), dim3(512), LDS_BYTES, stream, a);
    } else {
        for (int li = 0; li < NPH; ++li) { a.ph_lo = li; a.ph_hi = li + 1; hipLaunchKernelGGL(mk_fwd, dim3(grid), dim3(512), LDS_BYTES, stream, a); }
    }
    const hipError_t le = hipPeekAtLastError();
    if (le != hipSuccess) fprintf(stderr, "kernel_launch: launch failed: %s\n", hipGetErrorName(le));
}
```

```cpp
#include <hip/hip_runtime.h>
#include <cstdio>
#include <cstdint>

#ifndef MK_DUP
#define MK_DUP 0
#endif
#ifndef MK_F8_WOUT
#define MK_F8_WOUT 0
#endif
#ifndef MK_F8_WO
#define MK_F8_WO 1
#endif
#ifndef MK_F8_PROJ
#define MK_F8_PROJ 0
#endif
#ifndef MK_F8_PLEG
#define MK_F8_PLEG 0
#endif
#ifndef MK_N_LAUNCHES
#define MK_N_LAUNCHES 1
#endif

#define DI __device__ __forceinline__
#define LAS __attribute__((address_space(3)))
typedef unsigned short bf16_t;
typedef short bf16x8 __attribute__((ext_vector_type(8)));
typedef short s16x4 __attribute__((ext_vector_type(4)));
typedef float f32x4 __attribute__((ext_vector_type(4)));
typedef unsigned u32x4 __attribute__((ext_vector_type(4)));
typedef unsigned u32x2 __attribute__((ext_vector_type(2)));
typedef int i32x8 __attribute__((ext_vector_type(8)));
typedef short s16x16 __attribute__((ext_vector_type(16)));

constexpr int NB = 2, SEQ = 16384, T = NB * SEQ, DM = 2048, PLE = 256;
constexpr int NQKV = 9216, NHEAD = 8, HD = 128;
constexpr int NEXP = 64, DEXP = 512, SLOTCAP = 32768;
constexpr float EPS = 1e-6f;
constexpr int NPH = 27;
constexpr int N_LAUNCHES = MK_N_LAUNCHES;
static_assert(N_LAUNCHES == 1 || N_LAUNCHES == NPH, "MK_N_LAUNCHES is 1 or 27");

constexpr size_t MiB = 1u << 20;
constexpr size_t WS_CTL = 0, CTL_ZERO_BYTES = 2 * MiB;
constexpr int CW_BAR = 1024;
constexpr int CW_CNT = 8192;
constexpr int CW_ROWSS = 65536;
constexpr size_t WS_RSX = 2 * MiB, WS_RSH3 = 2 * MiB + 256 * 1024, WS_CLAM = 2 * MiB + 512 * 1024;
constexpr size_t WS_W_IN = 4 * MiB, WS_W_G = 20 * MiB, WS_W_OUT = 22 * MiB, WS_W_QKV = 30 * MiB, WS_W_O = 66 * MiB, WS_W_R = 70 * MiB, WS_W_PP = 72 * MiB,
                 WS_W_PG = 74 * MiB, WS_W_GU = 90 * MiB, WS_W_D = 602 * MiB;
constexpr size_t WS_HB = 858 * MiB, WS_PB = 986 * MiB, WS_COS = 1018 * MiB, WS_SIN = 1026 * MiB, WS_LOGITS = 1034 * MiB, WS_SLOT_AID = 1050 * MiB,
                 WS_SLOT_GATE = 1058 * MiB, WS_SP = 1066 * MiB, WS_SH = 1068 * MiB, WS_CIN = 1070 * MiB, WS_LSE = 1072 * MiB, WS_SCR = 1076 * MiB;
constexpr size_t WS_PROJ = WS_SCR, WS_XC = WS_SCR + 256 * MiB, WS_LA = WS_SCR + 384 * MiB, WS_U = WS_SCR + 512 * MiB;
constexpr size_t WS_QKV = WS_SCR, WS_OG = WS_SCR + 576 * MiB, WS_OB = WS_SCR + 768 * MiB;
constexpr size_t WS_HID = WS_SCR, WS_YB = WS_SCR + 80 * MiB, WS_EG = WS_SCR + 336 * MiB;
constexpr size_t WS_H8 = WS_SCR + 832 * MiB;
constexpr size_t WS_END = WS_H8 + 64 * MiB;
static_assert(WS_END <= 2048 * MiB, "workspace map");

constexpr int RING_BYTES = 131072, MISC_OFF = RING_BYTES, LDS_BYTES = 147456;
constexpr int MO_BARW = 0, MO_CNT = 64, MO_MTPRE = 320, MO_T2E = 640, MO_HIST = 1280;

typedef _Float16 h16x2 __attribute__((ext_vector_type(2)));
typedef float f32x2_t __attribute__((ext_vector_type(2)));
typedef __bf16 bf16x2_t __attribute__((ext_vector_type(2)));
DI unsigned cvt_pk_bf16(float lo, float hi) { const f32x2_t v = {lo, hi}; return __builtin_bit_cast(unsigned, __builtin_convertvector(v, bf16x2_t)); }
DI unsigned pk4_fp8(float a, float b, float c, float d) { unsigned w = 0u; w = __builtin_amdgcn_cvt_pk_fp8_f32(a, b, w, false); w = __builtin_amdgcn_cvt_pk_fp8_f32(c, d, w, true); return w; }
DI void unpack8_fp8(const u32x2 w, float (&v)[8]) { const f32x2_t a = __builtin_amdgcn_cvt_pk_f32_fp8(w.x, false), b = __builtin_amdgcn_cvt_pk_f32_fp8(w.x, true), c = __builtin_amdgcn_cvt_pk_f32_fp8(w.y, false), d = __builtin_amdgcn_cvt_pk_f32_fp8(w.y, true);
    v[0] = a[0]; v[1] = a[1]; v[2] = b[0]; v[3] = b[1]; v[4] = c[0]; v[5] = c[1]; v[6] = d[0]; v[7] = d[1]; }
DI float bflo(unsigned w) { return __uint_as_float(w << 16); }
DI float bfhi(unsigned w) { return __uint_as_float(w & 0xffff0000u); }
DI u32x4 pack8(const f32x4 a, const f32x4 b) { u32x4 w; w.x = cvt_pk_bf16(a[0], a[1]); w.y = cvt_pk_bf16(a[2], a[3]); w.z = cvt_pk_bf16(b[0], b[1]); w.w = cvt_pk_bf16(b[2], b[3]); return w; }
DI void unpack8(const u32x4 w, float (&v)[8]) { v[0] = bflo(w.x); v[1] = bfhi(w.x); v[2] = bflo(w.y); v[3] = bfhi(w.y); v[4] = bflo(w.z); v[5] = bfhi(w.z); v[6] = bflo(w.w); v[7] = bfhi(w.w); }
template <int CTRL> DI float dpp_mov(float v) { return __builtin_bit_cast(float, __builtin_amdgcn_update_dpp(0, __builtin_bit_cast(int, v), CTRL, 0xf, 0xf, false)); }
DI float row16_sum(float v) {
    v += dpp_mov<0xB1>(v);
    v += dpp_mov<0x4E>(v);
    v += dpp_mov<0x141>(v);
    v += dpp_mov<0x140>(v);
    return v;
}
DI float row16_xor8(float v) { return dpp_mov<0x128>(v); }
DI float wave_sum(float v) {
#pragma unroll
    for (int o = 1; o < 64; o <<= 1) v += __shfl_xor(v, o);
    return v;
}
typedef unsigned long long rs_t;
constexpr float RS_SCALE = 1048576.0f, RS_INV = 1.0f / (1048576.0f * 2048.0f);
DI rs_t rs_fix(float ss) { return (rs_t)(ss * RS_SCALE + 0.5f); }
DI float rs_rstd(rs_t v) { return __builtin_amdgcn_rsqf((float)v * RS_INV + 1e-6f); }
DI float sigmoidf_(float x) { return __builtin_amdgcn_rcpf(1.0f + __expf(-x)); }
typedef __attribute__((address_space(4))) const unsigned long long ka_u64;
#define GAS __attribute__((address_space(1)))
DI const void* karg_ptr(int i) { ka_u64* kb = (ka_u64*)__builtin_amdgcn_kernarg_segment_ptr(); asm volatile("" : "+s"(kb)); return (const void*)(const GAS void*)kb[i]; }
#define KF(i) ((const float*)karg_ptr(i))
enum { A_X = 0, A_P, A_POS, A_NORM_MIX, A_NORM_FFN, A_W_IN, A_CONV_W, A_CONV_B, A_W_RG, A_B_RG, A_W_IG, A_B_IG, A_LAM, A_W_OUT, A_W_QKV, A_Q_GAIN, A_K_GAIN, A_W_O,
       A_W_GROUP, A_B_GROUP, A_W_EXPERT, A_B_EXPERT, A_W_GATE, A_W_UP, A_W_DOWN, A_PLE_PROJ, A_PLE_GATE, A_PLE_NORM, A_OUT, A_WS };
#define LDS_WAIT() asm volatile("s_waitcnt lgkmcnt(0)" ::: "memory")
#define VM_WAIT() asm volatile("s_waitcnt vmcnt(0)" ::: "memory")

#define XB_TMO      128
#define XB_XCNT(j)  (256  + 64 * (j))
#define XB_XSUB(j)  (1280 + 64 * (j))
#define XB_XGEN(j)  (2304 + 64 * (j))
#define XB_TOP      3328
#define XB_TOPGEN   3392
#define XCD_BAR_WORDS 3456
#define XB_SPIN_CAP (1u << 21)

__device__ __forceinline__ unsigned xb_ld(unsigned* p)              { return __hip_atomic_load(p, __ATOMIC_RELAXED, __HIP_MEMORY_SCOPE_AGENT); }
__device__ __forceinline__ unsigned xb_add(unsigned* p, unsigned v) { return __hip_atomic_fetch_add(p, v, __ATOMIC_RELAXED, __HIP_MEMORY_SCOPE_AGENT); }
__device__ __forceinline__ unsigned xb_xcc_id() { return (unsigned)__builtin_amdgcn_s_getreg((3 << 11) | 20) & 0xFu; }
#define XB_SPIN(cond, bar) do { unsigned _sp = 0; while (cond) { __builtin_amdgcn_s_sleep(1); \
    if ((++_sp & 255u) == 0u) { if (xb_ld(&(bar)[XB_TMO])) break; if (_sp > XB_SPIN_CAP) { atomicAdd(&(bar)[XB_TMO], 1u); break; } } } } while (0)

struct XcdBarrier {
    unsigned* bar; unsigned x;
    volatile LAS unsigned* st;
};
__device__ __forceinline__ XcdBarrier xcd_barrier_post(unsigned* bar, volatile LAS unsigned* st, const int tid) {
    XcdBarrier b; b.bar = bar; b.x = xb_xcc_id(); b.st = st;
    if (tid == 0) (void)xb_add(&bar[XB_XCNT(b.x)], 1u);
    return b;
}
__device__ __forceinline__ void xcd_barrier_complete(unsigned* bar, unsigned x, unsigned& nloc, unsigned& nx) {
    const unsigned G = gridDim.x * gridDim.y * gridDim.z;
    unsigned sum, cnt, mine, sp = 0u;
    for (;;) {
        sum = 0u; cnt = 0u; mine = 0u;
#pragma unroll
        for (unsigned j = 0; j < 16; ++j) { const unsigned c = xb_ld(&bar[XB_XCNT(j)]); sum += c; cnt += (c > 0u) ? 1u : 0u; mine = (j == x) ? c : mine; }
        if (sum == G) break;
        __builtin_amdgcn_s_sleep(1);
        if ((++sp & 255u) == 0u) { if (xb_ld(&bar[XB_TMO])) break; if (sp > XB_SPIN_CAP) { atomicAdd(&bar[XB_TMO], 1u); break; } }
    }
    nloc = mine > 0u ? mine : 1u; nx = cnt > 0u ? cnt : 1u;
}
__device__ __forceinline__ void xcd_barrier(const XcdBarrier& b, const int tid) {
    asm volatile("s_waitcnt vmcnt(0)" ::: "memory");
    __syncthreads();
    if (tid == 0) {
        unsigned* bar = b.bar;
        __builtin_amdgcn_s_waitcnt(0);
        unsigned nloc = b.st[0], nx = b.st[1];
        if (nloc == 0u) { xcd_barrier_complete(bar, b.x, nloc, nx); b.st[0] = nloc; b.st[1] = nx; }
        const unsigned old = xb_add(&bar[XB_XSUB(b.x)], 1u);
        const unsigned gen = old / nloc;
        if (old + 1u == (gen + 1u) * nloc) {
            __builtin_amdgcn_fence(__ATOMIC_RELEASE, "agent");
            asm volatile("s_waitcnt vmcnt(0)" ::: "memory");
            const unsigned og = xb_add(&bar[XB_TOP], 1u);
            const unsigned tg = og / nx;
            if (og + 1u == (tg + 1u) * nx) xb_add(&bar[XB_TOPGEN], 1u);
            else XB_SPIN(xb_ld(&bar[XB_TOPGEN]) == tg, bar);
            __builtin_amdgcn_fence(__ATOMIC_ACQUIRE, "agent");
            xb_add(&bar[XB_XGEN(b.x)], 1u);
            asm volatile("s_waitcnt vmcnt(0)" ::: "memory");
        } else {
            XB_SPIN(xb_ld(&bar[XB_XGEN(b.x)]) == gen, bar);
            __builtin_amdgcn_fence(__ATOMIC_ACQUIRE, "agent");
            asm volatile("s_waitcnt vmcnt(0)" ::: "memory");
        }
    }
    __syncthreads();
}

namespace g8 {
constexpr int BM = 256, BK = 64, HALF = 128, HTB = HALF * BK * 2, NXCD = 8, WGM = 8;
DI int lds_byte(int r, int c) { const int st = (r >> 4) * 2 + (c >> 5), rr = r & 15, cc = c & 31, ob = rr * 64 + cc * 2; return st * 1024 + (ob ^ (((ob >> 9) & 1) << 5)); }
DI void stage_rc(int b, int& R, int& C) { const int st = b / 1024, sb = b % 1024, swz = sb ^ (((sb >> 9) & 1) << 5); R = (st >> 1) * 16 + swz / 64; C = (st & 1) * 32 + (swz % 64) / 2; }
DI int s8(int fr) { return ((fr >> 1) & 1) | (((-(fr >> 2)) & 3) << 1); }
DI int lds_byte8(int r, int cbyte) { return r * 128 + ((((cbyte >> 4) ^ s8(r & 15)) << 4) | (cbyte & 15)); }
DI void stage_rc8(int b, int& R, int& Cbyte) { R = b >> 7; Cbyte = (((b >> 4) & 7) ^ s8(R & 15)) << 4; }
DI int perm32(int rho) { const int n = rho >> 4, i = rho & 15; return 8 * (i >> 2) + 4 * n + (i & 3); }

struct Unit { const char* a; const char* b; int r0, c0, x0, x1, x2; };

DI int xcd_remap(int L, int nwg) { const int q = nwg / NXCD, r = nwg % NXCD, xcd = L % NXCD, off = L / NXCD; return (xcd < r ? xcd * (q + 1) : r * (q + 1) + (xcd - r) * q) + off; }

struct StaticSched {
    static constexpr bool GATHER = false;
    const char* A; const char* B; unsigned lda, ldb; int nM, nN, nwg, G, c;
    DI void init(const void* A_, unsigned lda_, const void* B_, unsigned ldb_, int nM_, int nN_, int G_, int c_) { A = (const char*)A_; B = (const char*)B_; lda = lda_; ldb = ldb_; nM = nM_; nN = nN_; nwg = nM * nN; G = G_; c = c_; }
    DI bool next(int i, Unit& u) const {
        const int L = i * G + c; if (L >= nwg) return false;
        const int wgid = xcd_remap(L, nwg);
        const int nig = WGM * nN, gid = wgid / nig, fm = gid * WGM, gsz = (nM - fm) < WGM ? (nM - fm) : WGM;
        const int pm = fm + ((wgid % nig) % gsz), pn = (wgid % nig) / gsz;
        u.a = A + (size_t)pm * 256 * lda; u.b = B + (size_t)pn * 256 * ldb; u.r0 = pm * 256; u.c0 = pn * 256; u.x0 = 0; u.x1 = 0; u.x2 = 0; return true;
    }
    DI unsigned gather(const Unit&, int) const { return 0u; }
};
struct GateSched {
    static constexpr bool GATHER = false;
    const char* A; const char* B; int nwg, G, c;
    DI void init(const void* A_, const void* B_, int G_, int c_) { A = (const char*)A_; B = (const char*)B_; nwg = (T / 256) * 16; G = G_; c = c_; }
    DI bool next(int i, Unit& u) const {
        const int L = i * G + c; if (L >= nwg) return false;
        const int wgid = xcd_remap(L, nwg);
        const int nN = 16, nM = T / 256, nig = WGM * nN, gid = wgid / nig, fm = gid * WGM, gsz = (nM - fm) < WGM ? (nM - fm) : WGM;
        const int pm = fm + ((wgid % nig) % gsz), pn = (wgid % nig) / gsz, blk = pn >> 1, j = pn & 1;
        u.a = A + (size_t)pm * 256 * (DM * 2) + blk * 512; u.b = B + (size_t)pn * 256 * 512; u.r0 = pm * 256; u.c0 = blk * 256 + j * 128; u.x0 = 0; u.x1 = 0; u.x2 = 0; return true;
    }
    DI unsigned gather(const Unit&, int) const { return 0u; }
};
template <int NJ, bool GATH> struct MoeSched {
    static constexpr bool GATHER = GATH;
    const char* A; const char* B; unsigned lda, ldbt  ; size_t bexp  ; const int* slot_aid; LAS unsigned char* misc; int nwg, G, c;
    DI void init(const void* A_, unsigned lda_, const void* B_, unsigned ldb_, size_t bexp_, const int* slot_aid_, LAS unsigned char* misc_, int G_, int c_) {
        A = (const char*)A_; lda = lda_; B = (const char*)B_; ldbt = 256u * ldb_; bexp = bexp_; slot_aid = slot_aid_; misc = misc_; G = G_; c = c_;
        nwg = ((const LAS int*)(misc + MO_MTPRE))[64] * NJ; }
    DI bool next(int i, Unit& u) const {
        const int L = i * G + c; if (L >= nwg) return false;
        const int idx = xcd_remap(L, nwg), mt = idx / NJ, j = idx % NJ;
        const int e = __builtin_amdgcn_readfirstlane((int)((const LAS unsigned char*)(misc + MO_T2E))[mt]);
        const int pre = __builtin_amdgcn_readfirstlane(((const LAS int*)(misc + MO_MTPRE))[e]);
        const int cn = __builtin_amdgcn_readfirstlane(((const LAS int*)(misc + MO_CNT))[e]);
        const int pos0 = (mt - pre) * 256;
        u.a = GATH ? A : A + (size_t)mt * 256 * lda; u.b = B + (size_t)e * bexp + (size_t)j * ldbt;
        u.r0 = mt * 256; u.c0 = j; u.x0 = e * SLOTCAP + pos0; u.x1 = pos0; u.x2 = cn - pos0; return true;
    }
    DI unsigned gather(const Unit& u, int row) const { const int rc = row < u.x2 ? row : u.x2 - 1; const int aid = slot_aid[u.x0 + rc]; return (unsigned)(aid >> 1) * lda; }
};

template <class Epi, class Sched>
DI void gemm_phase(LAS unsigned char* lds, const int tid, const int K, const unsigned lda, const unsigned ldb, const Sched& S, const Epi& E) {
    const int wid = __builtin_amdgcn_readfirstlane(tid >> 6), lane = tid & 63, wr = wid >> 2, wc = wid & 3, fr = lane & 15, fq = lane >> 4;
    const int nt = K / BK;
    unsigned voffA[2], voffB[2]; int rowA[2]; unsigned colA[2];
#pragma unroll
    for (int i = 0; i < 2; ++i) { int R, C2; if constexpr (Epi::FP8) stage_rc8(tid * 16 + i * 8192, R, C2); else { int C; stage_rc(tid * 16 + i * 8192, R, C); C2 = C * 2; }
        const int Rb = Epi::PERM ? ((R & ~31) + perm32(R & 31)) : R;
        voffA[i] = (unsigned)R * lda + (unsigned)C2; voffB[i] = (unsigned)Rb * ldb + (unsigned)C2; rowA[i] = R; colA[i] = (unsigned)C2; }
    const size_t kstep = (size_t)(BK * 2);
    const size_t hA = (size_t)HALF * lda, hB = (size_t)HALF * ldb;
    const unsigned ldsw = (unsigned)wid * 1024u;
    constexpr bool FP8 = Epi::FP8; constexpr bool HALFN = Epi::HALFN;
    const int aoff = FP8 ? lds_byte8(wr * 64 + fr, 32 * fq) : lds_byte(wr * 64 + fr, fq * 8), boff = FP8 ? lds_byte8(wc * 32 + fr, 32 * fq) : lds_byte(wc * 32 + fr, fq * 8);
    const int aoff1 = aoff ^ 16, boff1 = boff ^ 16;
    unsigned gc[2][2] = {{0u, 0u}, {0u, 0u}}, gn[2][2] = {{0u, 0u}, {0u, 0u}};
#define G8_SA(b, h) (((b) * 2 + (h)) * HTB)
#define G8_SB(b, h) ((4 + (b) * 2 + (h)) * HTB)
#define G8_GLDS(gp, ldsoff) __builtin_amdgcn_global_load_lds((const unsigned*)(gp), (LAS unsigned*)(lds + (ldsoff)), 16, 0, 0)
#define G8_STAGE_B(bufoff, gbase) do { G8_GLDS((gbase) + voffB[0], (bufoff) + ldsw); G8_GLDS((gbase) + voffB[1], (bufoff) + ldsw + 8192); } while (0)
#define G8_STAGE_A(bufoff, kptr, h, nx) do { if constexpr (Sched::GATHER) { \
        const unsigned o0_ = (nx) ? gn[h][0] : gc[h][0], o1_ = (nx) ? gn[h][1] : gc[h][1]; \
        G8_GLDS((kptr) + o0_, (bufoff) + ldsw); G8_GLDS((kptr) + o1_, (bufoff) + ldsw + 8192); } \
    else { G8_GLDS((kptr) + (h) * hA + voffA[0], (bufoff) + ldsw); G8_GLDS((kptr) + (h) * hA + voffA[1], (bufoff) + ldsw + 8192); } } while (0)
#define G8_LDA(b, h) do { if constexpr (FP8) { _Pragma("unroll") for (int m = 0; m < 4; ++m) { const bf16x8 lo_ = *(const LAS bf16x8*)(lds + G8_SA(b, h) + aoff + m * 2048), hi_ = *(const LAS bf16x8*)(lds + G8_SA(b, h) + aoff1 + m * 2048); A8[m] = __builtin_bit_cast(i32x8, __builtin_shufflevector(lo_, hi_, 0, 1, 2, 3, 4, 5, 6, 7, 8, 9, 10, 11, 12, 13, 14, 15)); } } \
    else { _Pragma("unroll") for (int m = 0; m < 4; ++m) _Pragma("unroll") for (int k = 0; k < 2; ++k) At[m][k] = *(const LAS bf16x8*)(lds + G8_SA(b, h) + aoff + m * 2048 + k * 1024); } } while (0)
#define G8_LDB(w, b, h) do { if constexpr (FP8) { _Pragma("unroll") for (int n = 0; n < 2; ++n) { const bf16x8 lo_ = *(const LAS bf16x8*)(lds + G8_SB(b, h) + boff + n * 2048), hi_ = *(const LAS bf16x8*)(lds + G8_SB(b, h) + boff1 + n * 2048); B8[w][n] = __builtin_bit_cast(i32x8, __builtin_shufflevector(lo_, hi_, 0, 1, 2, 3, 4, 5, 6, 7, 8, 9, 10, 11, 12, 13, 14, 15)); } } \
    else { _Pragma("unroll") for (int n = 0; n < 2; ++n) _Pragma("unroll") for (int k = 0; k < 2; ++k) Bq[w][n][k] = *(const LAS bf16x8*)(lds + G8_SB(b, h) + boff + n * 2048 + k * 1024); } } while (0)
#define G8_MMA(ai, bj, w) do { __builtin_amdgcn_s_setprio(1); if constexpr (FP8) { _Pragma("unroll") for (int m = 0; m < 4; ++m) _Pragma("unroll") for (int n = 0; n < 2; ++n) \
        asm volatile("v_mfma_scale_f32_16x16x128_f8f6f4 %0, %1, %2, %0, %3, %3 op_sel_hi:[0,0,0]" : "+v"(acc[ai][bj][m][n]) : "v"(B8[w][n]), "v"(A8[m]), "v"(one_scale)); } \
    else { _Pragma("unroll") for (int m = 0; m < 4; ++m) _Pragma("unroll") for (int n = 0; n < 2; ++n) _Pragma("unroll") for (int k = 0; k < 2; ++k) \
        acc[ai][bj][m][n] = __builtin_amdgcn_mfma_f32_16x16x32_bf16(Bq[w][n][k], At[m][k], acc[ai][bj][m][n], 0, 0, 0); } __builtin_amdgcn_s_setprio(0); } while (0)
#define G8_WAIT_V(n) asm volatile("s_waitcnt vmcnt(" #n ")" ::: "memory")
#define G8_WAIT_L(n) asm volatile("s_waitcnt lgkmcnt(" #n ")" ::: "memory")
#define G8_BAR __builtin_amdgcn_s_barrier()
#define G8_SCHED __builtin_amdgcn_sched_barrier(0)
#define G8_GOFF(dst, u) do { if constexpr (Sched::GATHER) { _Pragma("unroll") for (int h_ = 0; h_ < 2; ++h_) _Pragma("unroll") for (int i_ = 0; i_ < 2; ++i_) dst[h_][i_] = S.gather(u, h_ * 128 + rowA[i_]) + colA[i_]; } } while (0)
    Unit cur, nxt; int ui = 0;
    if (!S.next(0, cur)) return;
    f32x4 acc[2][2][4][2];
#pragma unroll
    for (int a = 0; a < 2; ++a)
#pragma unroll
        for (int b = 0; b < 2; ++b)
#pragma unroll
            for (int m = 0; m < 4; ++m)
#pragma unroll
                for (int n = 0; n < 2; ++n) acc[a][b][m][n] = (f32x4){0.f, 0.f, 0.f, 0.f};
    bf16x8 At[4][2], Bq[2][2][2]; i32x8 A8[4], B8[2][2];
    const int one_scale = 0x7f7f7f7f;
    const char* cA = cur.a; const char* cB = cur.b;
    G8_GOFF(gc, cur);
    G8_STAGE_B(G8_SB(0, 0), cB); G8_STAGE_B(G8_SB(0, 1), cB + hB); G8_STAGE_A(G8_SA(0, 0), cA, 0, false); G8_STAGE_A(G8_SA(0, 1), cA, 1, false);
    if (wr == 1) G8_BAR;
    G8_WAIT_V(2); G8_BAR;
    G8_STAGE_B(G8_SB(1, 0), cB + kstep); G8_STAGE_A(G8_SA(1, 0), cA + kstep, 0, false); G8_STAGE_B(G8_SB(1, 1), cB + hB + kstep);
    G8_WAIT_V(6); G8_BAR;
    for (;;) {
        const bool has_next = S.next(ui + 1, nxt);
        const char* nA = has_next ? nxt.a : cA; const char* nB = has_next ? nxt.b : cB;
        if constexpr (Sched::GATHER) { if (has_next) { G8_GOFF(gn, nxt); } else {
#pragma unroll
            for (int h_ = 0; h_ < 2; ++h_)
#pragma unroll
                for (int i_ = 0; i_ < 2; ++i_) gn[h_][i_] = gc[h_][i_]; } }
        for (int t = 0; t < nt; t += 2) {
            const bool last = (t == nt - 2);
            const char* a1 = cA + (size_t)(t + 1) * kstep;
            const char* a2 = last ? nA : cA + (size_t)(t + 2) * kstep; const char* b2 = last ? nB : cB + (size_t)(t + 2) * kstep;
            const char* a3 = a2 + kstep; const char* b3 = b2 + kstep;
            G8_LDB(0, 0, 0); if constexpr (!HALFN) G8_LDB(1, 0, 1); G8_SCHED; G8_LDA(0, 0); G8_STAGE_A(G8_SA(1, 1), a1, 1, false);
            G8_WAIT_V(8); G8_WAIT_L(0); G8_BAR; G8_MMA(0, 0, 0); if constexpr (!HALFN) G8_MMA(0, 1, 1); G8_BAR; G8_SCHED;
            G8_LDA(0, 1); G8_STAGE_B(G8_SB(0, 0), b2); G8_STAGE_B(G8_SB(0, 1), b2 + hB); G8_STAGE_A(G8_SA(0, 0), a2, 0, last);
            G8_WAIT_V(8); G8_WAIT_L(0); G8_BAR; G8_MMA(1, 0, 0); if constexpr (!HALFN) G8_MMA(1, 1, 1); G8_BAR; G8_SCHED;
            G8_LDB(0, 1, 0); if constexpr (!HALFN) G8_LDB(1, 1, 1); G8_SCHED; G8_LDA(1, 0); G8_STAGE_A(G8_SA(0, 1), a2, 1, last);
            G8_WAIT_V(8); G8_WAIT_L(0); G8_BAR; G8_MMA(0, 0, 0); if constexpr (!HALFN) G8_MMA(0, 1, 1); G8_BAR; G8_SCHED;
            G8_LDA(1, 1); G8_STAGE_B(G8_SB(1, 0), b3); G8_STAGE_B(G8_SB(1, 1), b3 + hB); G8_STAGE_A(G8_SA(1, 0), a3, 0, last);
            G8_WAIT_V(8); G8_WAIT_L(0); G8_BAR; G8_MMA(1, 0, 0); if constexpr (!HALFN) G8_MMA(1, 1, 1); G8_BAR; G8_SCHED;
        }
        if (wr == 0) G8_BAR;
        if constexpr (FP8) asm volatile("s_nop 15\n\ts_nop 15" ::: "memory");
        { int l2 = (int)__builtin_amdgcn_mbcnt_hi(~0u, __builtin_amdgcn_mbcnt_lo(~0u, 0u)); asm volatile("" : "+v"(l2));
          E(acc, cur, wr, wc, l2 & 15, l2 >> 4); }
        if (!has_next) break;
#pragma unroll
        for (int a = 0; a < 2; ++a)
#pragma unroll
            for (int b = 0; b < 2; ++b)
#pragma unroll
                for (int m = 0; m < 4; ++m)
#pragma unroll
                    for (int n = 0; n < 2; ++n) acc[a][b][m][n] = (f32x4){0.f, 0.f, 0.f, 0.f};
        cur = nxt; cA = nA; cB = nB; ++ui;
        if constexpr (Sched::GATHER) {
#pragma unroll
            for (int h_ = 0; h_ < 2; ++h_)
#pragma unroll
                for (int i_ = 0; i_ < 2; ++i_) gc[h_][i_] = gn[h_][i_]; }
        if (wr == 1) G8_BAR;
    }
    G8_WAIT_V(0);
    G8_BAR;
#undef G8_SA
#undef G8_SB
#undef G8_GLDS
#undef G8_STAGE_A
#undef G8_STAGE_B
#undef G8_LDA
#undef G8_LDB
#undef G8_MMA
#undef G8_WAIT_V
#undef G8_WAIT_L
#undef G8_BAR
#undef G8_SCHED
#undef G8_GOFF
}

#define EPI_ROWS(ai, m) ((ai) * 128 + wr * 64 + (m) * 16 + fr)

template <bool F8> struct EpiBf16ScaleT {
    static constexpr bool PERM = true; static constexpr bool FP8 = F8; static constexpr bool HALFN = false;
    bf16_t* O; int ldc; const rs_t* rowss; float mul;
    DI void operator()(const f32x4 (&acc)[2][2][4][2], const Unit& u, int wr, int wc, int fr, int fq) const {
        rs_t rs[2][4];
#pragma unroll
        for (int ai = 0; ai < 2; ++ai)
#pragma unroll
            for (int m = 0; m < 4; ++m) rs[ai][m] = rowss ? rowss[u.r0 + EPI_ROWS(ai, m)] : 0ull;
#pragma unroll
        for (int ai = 0; ai < 2; ++ai)
#pragma unroll
            for (int m = 0; m < 4; ++m) {
                const int row = u.r0 + EPI_ROWS(ai, m);
                const float sc = (rowss ? rs_rstd(rs[ai][m]) : 1.0f) * mul;
                bf16_t* rowp = O + (size_t)row * ldc + u.c0 + wc * 32 + 8 * fq;
#pragma unroll
                for (int bj = 0; bj < 2; ++bj) *(u32x4*)(rowp + bj * 128) = pack8(acc[ai][bj][m][0] * sc, acc[ai][bj][m][1] * sc);
            }
    }
};
typedef EpiBf16ScaleT<false> EpiBf16Scale;
DI int qkv_plane_row(int t, int dsh) { const int b = t >> 14, sp = t & (SEQ - 1); return (b << 14) + (sp & ((1 << dsh) - 1)) * (SEQ >> dsh) + (sp >> dsh); }
struct EpiQkvPlanes {
    static constexpr bool PERM = true; static constexpr bool FP8 = true; static constexpr bool HALFN = false;
    unsigned char* O; const rs_t* rowss; float mul;
    DI void operator()(const f32x4 (&acc)[2][2][4][2], const Unit& u, int wr, int wc, int fr, int fq) const {
        const int pn = u.c0 >> 8, g = pn / 12, dsh = 2 * g;
        const size_t plane0 = (size_t)(pn >> 2) * 8 + (pn & 3) * 2;
        rs_t rs[2][4];
#pragma unroll
        for (int ai = 0; ai < 2; ++ai)
#pragma unroll
            for (int m = 0; m < 4; ++m) rs[ai][m] = rowss[u.r0 + EPI_ROWS(ai, m)];
#pragma unroll
        for (int ai = 0; ai < 2; ++ai)
#pragma unroll
            for (int m = 0; m < 4; ++m) {
                const int prow = qkv_plane_row(u.r0 + EPI_ROWS(ai, m), dsh);
                const float sc = rs_rstd(rs[ai][m]) * mul;
                unsigned char* rowp = O + (plane0 * T + prow) * HD + wc * 32 + 8 * fq;
#pragma unroll
                for (int bj = 0; bj < 2; ++bj) { const f32x4 a0 = acc[ai][bj][m][0] * sc, a1 = acc[ai][bj][m][1] * sc; u32x2 q; q.x = pk4_fp8(a0[0], a0[1], a0[2], a0[3]); q.y = pk4_fp8(a1[0], a1[1], a1[2], a1[3]); *(u32x2*)(rowp + (size_t)bj * T * HD) = q; }
            }
    }
};
struct EpiGates {
    static constexpr bool PERM = true; static constexpr bool FP8 = false; static constexpr bool HALFN = false;
    const bf16_t* XC; const float* b_rg; const float* b_ig; const float* clam; bf16_t* LA; bf16_t* U;
    DI void operator()(const f32x4 (&acc)[2][2][4][2], const Unit& u, int wr, int wc, int fr, int fq) const {
        const int ch = u.c0 + wc * 32 + 8 * fq;
        float br[8], bi[8], cl[8];
        { const f32x4 a = *(const f32x4*)(b_rg + ch), b = *(const f32x4*)(b_rg + ch + 4), c = *(const f32x4*)(b_ig + ch), d = *(const f32x4*)(b_ig + ch + 4), e = *(const f32x4*)(clam + ch), f = *(const f32x4*)(clam + ch + 4);
#pragma unroll
          for (int j = 0; j < 4; ++j) { br[j] = a[j]; br[4 + j] = b[j]; bi[j] = c[j]; bi[4 + j] = d[j]; cl[j] = e[j]; cl[4 + j] = f[j]; } }
        const unsigned off0 = ((unsigned)(u.r0 + wr * 64 + fr) * DM + (unsigned)ch) * 2u;
#pragma unroll
        for (int ai = 0; ai < 2; ++ai)
#pragma unroll
            for (int m = 0; m < 4; ++m) {
                const unsigned off = off0 + (unsigned)((ai * 128 + m * 16) * DM * 2);
                float xv[8]; unpack8(*(const u32x4*)((const char*)XC + off), xv);
                float la[8], uu[8];
#pragma unroll
                for (int j = 0; j < 8; ++j) {
                    const float r = sigmoidf_(acc[ai][0][m][j >> 2][j & 3] + br[j]), ig = sigmoidf_(acc[ai][1][m][j >> 2][j & 3] + bi[j]);
                    const float l = r * cl[j];
                    la[j] = l;
                    const float om = 1.0f - __expf(2.0f * l);
                    uu[j] = __builtin_amdgcn_sqrtf(om > 0.f ? om : 0.f) * (ig * xv[j]);
                }
                u32x4 lw = pack8((f32x4){la[0], la[1], la[2], la[3]}, (f32x4){la[4], la[5], la[6], la[7]});
                u32x4 uw = pack8((f32x4){uu[0], uu[1], uu[2], uu[3]}, (f32x4){uu[4], uu[5], uu[6], uu[7]});
                asm volatile("" : "+v"(lw), "+v"(uw));
                *(u32x4*)((char*)LA + off) = lw; *(u32x4*)((char*)U + off) = uw;
                asm volatile("" ::: "memory");
            }
    }
};
template <bool F8> struct EpiResidT {
    static constexpr bool PERM = true; static constexpr bool FP8 = F8; static constexpr bool HALFN = false;
    bf16_t* hb; unsigned char* h8; rs_t* rowss; float mul;
    DI void operator()(const f32x4 (&acc)[2][2][4][2], const Unit& u, int wr, int wc, int fr, int fq) const {
        const unsigned off0 = ((unsigned)(u.r0 + wr * 64 + fr) * DM + (unsigned)(u.c0 + wc * 32 + 8 * fq)) * 2u;
#pragma unroll
        for (int ai = 0; ai < 2; ++ai)
#pragma unroll
            for (int m = 0; m < 4; ++m) {
                const int row = u.r0 + EPI_ROWS(ai, m);
                const unsigned off = off0 + (unsigned)((ai * 128 + m * 16) * DM * 2);
                float ss = 0.f;
#pragma unroll
                for (int bj = 0; bj < 2; ++bj) {
                    float rv[8]; unpack8(*(const u32x4*)((const char*)hb + off + bj * 256), rv);
                    const f32x4 h0 = (f32x4){rv[0], rv[1], rv[2], rv[3]} + acc[ai][bj][m][0] * mul, h1 = (f32x4){rv[4], rv[5], rv[6], rv[7]} + acc[ai][bj][m][1] * mul;
                    *(u32x4*)((char*)hb + off + bj * 256) = pack8(h0, h1);
                    { u32x2 q; q.x = pk4_fp8(h0[0], h0[1], h0[2], h0[3]); q.y = pk4_fp8(h1[0], h1[1], h1[2], h1[3]); *(u32x2*)(h8 + (off >> 1) + bj * 128) = q; }
                    ss += (h0[0] * h0[0] + h0[1] * h0[1]) + (h0[2] * h0[2] + h0[3] * h0[3]) + (h1[0] * h1[0] + h1[1] * h1[1]) + (h1[2] * h1[2] + h1[3] * h1[3]);
                }
                ss += __shfl_xor(ss, 16); ss += __shfl_xor(ss, 32);
                if (fq == 0) atomicAdd(rowss + row, rs_fix(ss));
            }
    }
};
struct EpiLogits {
    static constexpr bool PERM = false; static constexpr bool FP8 = false; static constexpr bool HALFN = true;
    float* L; const rs_t* rowss;
    DI void operator()(const f32x4 (&acc)[2][2][4][2], const Unit& u, int wr, int wc, int fr, int fq) const {
        rs_t rs[2][4];
#pragma unroll
        for (int ai = 0; ai < 2; ++ai)
#pragma unroll
            for (int m = 0; m < 4; ++m) rs[ai][m] = rowss[u.r0 + EPI_ROWS(ai, m)];
#pragma unroll
        for (int ai = 0; ai < 2; ++ai)
#pragma unroll
            for (int m = 0; m < 4; ++m) {
                const int row = u.r0 + EPI_ROWS(ai, m);
                const float sc = rs_rstd(rs[ai][m]);
                float* rowp = L + (size_t)row * 128 + wc * 32 + 4 * fq;
#pragma unroll
                for (int n = 0; n < 2; ++n) *(f32x4*)(rowp + n * 16) = acc[ai][0][m][n] * sc;
            }
    }
};
struct EpiGU {
    static constexpr bool PERM = true; static constexpr bool FP8 = true; static constexpr bool HALFN = false;
    unsigned char* HID; const int* slot_aid; const rs_t* rowss;
    DI void operator()(const f32x4 (&acc)[2][2][4][2], const Unit& u, int wr, int wc, int fr, int fq) const {
        int aid[2][4]; rs_t rs[2][4];
#pragma unroll
        for (int ai = 0; ai < 2; ++ai)
#pragma unroll
            for (int m = 0; m < 4; ++m) { const int rt = EPI_ROWS(ai, m); aid[ai][m] = slot_aid[u.x0 + (rt < u.x2 ? rt : u.x2 - 1)]; }
#pragma unroll
        for (int ai = 0; ai < 2; ++ai)
#pragma unroll
            for (int m = 0; m < 4; ++m) rs[ai][m] = rowss[aid[ai][m] >> 1];
#pragma unroll
        for (int ai = 0; ai < 2; ++ai)
#pragma unroll
            for (int m = 0; m < 4; ++m) {
                const int rt = EPI_ROWS(ai, m);
                const float sc = rs_rstd(rs[ai][m]) * (1.0f / 64.0f);
                f32x4 h[2];
#pragma unroll
                for (int n = 0; n < 2; ++n)
#pragma unroll
                    for (int j = 0; j < 4; ++j) { const float g = acc[ai][0][m][n][j] * sc, v = acc[ai][1][m][n][j] * sc; h[n][j] = g * sigmoidf_(g) * v; }
                u32x2 q; q.x = pk4_fp8(h[0][0], h[0][1], h[0][2], h[0][3]); q.y = pk4_fp8(h[1][0], h[1][1], h[1][2], h[1][3]);
                *(u32x2*)(HID + (size_t)(u.r0 + rt) * DEXP + u.c0 * 128 + wc * 32 + 8 * fq) = q;
            }
    }
};
struct EpiDown {
    static constexpr bool PERM = true; static constexpr bool FP8 = true; static constexpr bool HALFN = false;
    unsigned char* YB; const int* slot_aid; const float* slot_gate;
    DI void operator()(const f32x4 (&acc)[2][2][4][2], const Unit& u, int wr, int wc, int fr, int fq) const {
        int aid[2][4]; float gt[2][4];
#pragma unroll
        for (int ai = 0; ai < 2; ++ai)
#pragma unroll
            for (int m = 0; m < 4; ++m) { const int rt = EPI_ROWS(ai, m), rc = rt < u.x2 ? rt : u.x2 - 1; aid[ai][m] = slot_aid[u.x0 + rc]; gt[ai][m] = slot_gate[u.x0 + rc] * (16.0f / 64.0f); }
#pragma unroll
        for (int ai = 0; ai < 2; ++ai)
#pragma unroll
            for (int m = 0; m < 4; ++m) {
                const int rt = EPI_ROWS(ai, m);
                if (rt < u.x2) {
                    unsigned char* rowp = YB + (size_t)aid[ai][m] * DM + u.c0 * 256 + wc * 32 + 8 * fq;
#pragma unroll
                    for (int bj = 0; bj < 2; ++bj) { const f32x4 a0 = acc[ai][bj][m][0] * gt[ai][m], a1 = acc[ai][bj][m][1] * gt[ai][m]; u32x2 q; q.x = pk4_fp8(a0[0], a0[1], a0[2], a0[3]); q.y = pk4_fp8(a1[0], a1[1], a1[2], a1[3]); *(u32x2*)(rowp + bj * 128) = q; }
                }
            }
    }
};
template <bool F8> struct EpiPleGT {
    static constexpr bool PERM = true; static constexpr bool FP8 = F8; static constexpr bool HALFN = false;
    bf16_t* EG; rs_t* rowss; float mul;
    DI void operator()(const f32x4 (&acc)[2][2][4][2], const Unit& u, int wr, int wc, int fr, int fq) const {
#pragma unroll
        for (int ai = 0; ai < 2; ++ai)
#pragma unroll
            for (int m = 0; m < 4; ++m) {
                const int row = u.r0 + EPI_ROWS(ai, m);
                bf16_t* rowp = EG + (size_t)row * DM + u.c0 + wc * 32 + 8 * fq;
                float ss = 0.f;
#pragma unroll
                for (int bj = 0; bj < 2; ++bj) {
                    float ev[8]; unpack8(*(const u32x4*)(rowp + bj * 128), ev);
                    f32x4 o[2];
#pragma unroll
                    for (int j = 0; j < 8; ++j) { const float v = ev[j] * sigmoidf_(acc[ai][bj][m][j >> 2][j & 3] * mul); o[j >> 2][j & 3] = v; ss += v * v; }
                    *(u32x4*)(rowp + bj * 128) = pack8(o[0], o[1]);
                }
                ss += __shfl_xor(ss, 16); ss += __shfl_xor(ss, 32);
                if (fq == 0) atomicAdd(rowss + row, rs_fix(ss));
            }
    }
};
}

struct Ctx { LAS unsigned char* lds; int tid, lane, wave, G, bid; };

struct TrJob { const float* src; const float* gain; bf16_t* dst; int N, Kd; int f8; };
DI void tr_load(float (&v)[32], const TrJob& j, int lane) {
#pragma unroll
    for (int i = 0; i < 32; ++i) { const int kk = 2 * i + (lane >> 5); v[i] = j.src[(size_t)kk * j.N + (lane & 31)]; }
}
DI void tr_store(const float (&v)[32], const TrJob& jb, LAS float* scr, int lane) {
#pragma unroll
    for (int i = 0; i < 32; ++i) { const int kk = 2 * i + (lane >> 5); scr[kk * 33 + (lane & 31)] = v[i]; }
    LDS_WAIT(); asm volatile("" ::: "memory");
    const int c = lane & 7;
    float g[8];
#pragma unroll
    for (int j = 0; j < 8; ++j) g[j] = jb.gain ? jb.gain[8 * c + j] : 1.0f;
#pragma unroll
    for (int j = 0; j < 4; ++j) { const int n = (lane >> 3) + 8 * j; const LAS float* s = scr + (8 * c) * 33 + n;
        float t[8];
#pragma unroll
        for (int q = 0; q < 8; ++q) t[q] = s[q * 33] * g[q];
        if (jb.f8) { u32x2 o; o.x = pk4_fp8(t[0] * 64.f, t[1] * 64.f, t[2] * 64.f, t[3] * 64.f); o.y = pk4_fp8(t[4] * 64.f, t[5] * 64.f, t[6] * 64.f, t[7] * 64.f);
            *(u32x2*)((unsigned char*)jb.dst + (size_t)n * jb.Kd + 8 * c) = o; }
        else { u32x4 o; o.x = cvt_pk_bf16(t[0], t[1]); o.y = cvt_pk_bf16(t[2], t[3]); o.z = cvt_pk_bf16(t[4], t[5]); o.w = cvt_pk_bf16(t[6], t[7]);
            *(u32x4*)(jb.dst + (size_t)n * jb.Kd + 8 * c) = o; } }
    LDS_WAIT(); asm volatile("" ::: "memory");
}
DI void p0_prologue(const Ctx& F, unsigned char* ws) {
    LAS float* scr = (LAS float*)(F.lds + F.wave * 8704);
    const int gw = F.bid * 8 + F.wave, NGW = F.G * 8;
    const int gt = F.bid * 512 + F.tid, NGT = F.G * 512;
    constexpr int I_IN = 32 * 128, I_G = 8 * 4 * 8, I_OUT = 32 * 64, I_QKV = 32 * 288, I_O = 16 * 64, I_PP = 4 * 64, I_PG = 32 * 64, I_ME = 512;
    constexpr int N_SMALL = I_IN + 2 * I_G + I_OUT + I_QKV + I_O + 2 * I_PP + 2 * I_PG;
    constexpr int N_ITEMS = N_SMALL + 3 * 128 * I_ME;
#define TR_DECODE(IT, JOB) do { int r = (IT); const float* src; int N; const float* gain = nullptr; bf16_t* dst; int Kd; int f8 = 0; \
        if (r < I_IN) { const int kb = r / 128, nb = r % 128; src = KF(A_W_IN) + (size_t)kb * 64 * 4096 + nb * 32; N = 4096; gain = KF(A_NORM_MIX) + kb * 64; if (MK_F8_PROJ) { dst = (bf16_t*)(ws + WS_W_IN + (size_t)nb * 32 * 2048 + kb * 64); f8 = 1; } else dst = (bf16_t*)(ws + WS_W_IN) + (size_t)nb * 32 * 2048 + kb * 64; Kd = 2048; } \
        else if ((r -= I_IN) < 2 * I_G) { const int ig = r / I_G; r %= I_G; const int blk = r / 32, kb = (r % 32) / 8, nb = r % 8; const int n0 = nb * 32; \
            src = (ig ? KF(A_W_IG) : KF(A_W_RG)) + (size_t)blk * 65536 + (size_t)kb * 64 * 256 + n0; N = 256; \
            const int drow = blk * 512 + (n0 >> 7) * 256 + ig * 128 + (n0 & 127); \
            dst = (bf16_t*)(ws + WS_W_G) + (size_t)drow * 256 + kb * 64; Kd = 256; } \
        else if ((r -= 2 * I_G) < I_OUT) { const int kb = r / 64, nb = r % 64; src = KF(A_W_OUT) + (size_t)kb * 64 * 2048 + nb * 32; N = 2048; if (MK_F8_WOUT) { dst = (bf16_t*)(ws + WS_W_OUT + (size_t)nb * 32 * 2048 + kb * 64); f8 = 1; } else dst = (bf16_t*)(ws + WS_W_OUT) + (size_t)nb * 32 * 2048 + kb * 64; Kd = 2048; } \
        else if ((r -= I_OUT) < I_QKV) { const int kb = r / 288, nb = r % 288; src = KF(A_W_QKV) + (size_t)kb * 64 * NQKV + nb * 32; N = NQKV; gain = KF(A_NORM_MIX) + DM + kb * 64; dst = (bf16_t*)(ws + WS_W_QKV + (size_t)nb * 32 * 2048 + kb * 64); Kd = 2048; f8 = 1; } \
        else if ((r -= I_QKV) < I_O) { const int kb = r / 64, nb = r % 64; src = KF(A_W_O) + (size_t)kb * 64 * 2048 + nb * 32; N = 2048; if (MK_F8_WO) { dst = (bf16_t*)(ws + WS_W_O + (size_t)nb * 32 * 1024 + kb * 64); f8 = 1; } else dst = (bf16_t*)(ws + WS_W_O) + (size_t)nb * 32 * 1024 + kb * 64; Kd = 1024; } \
        else if ((r -= I_O) < 2 * I_PP) { const int l = r / I_PP; r %= I_PP; const int kb = r / 64, nb = r % 64; \
            src = KF(A_PLE_PROJ) + (size_t)l * 256 * 2048 + (size_t)kb * 64 * 2048 + nb * 32; N = 2048; dst = (bf16_t*)(ws + WS_W_PP + (size_t)l * MiB) + (size_t)nb * 32 * 256 + kb * 64; Kd = 256; } \
        else if ((r -= 2 * I_PP) < 2 * I_PG) { const int l = r / I_PG; r %= I_PG; const int kb = r / 64, nb = r % 64; \
            src = KF(A_PLE_GATE) + (size_t)l * 2048 * 2048 + (size_t)kb * 64 * 2048 + nb * 32; N = 2048; if (MK_F8_PLEG) { dst = (bf16_t*)(ws + WS_W_PG + (size_t)l * 8 * MiB + (size_t)nb * 32 * 2048 + kb * 64); f8 = 1; } else dst = (bf16_t*)(ws + WS_W_PG + (size_t)l * 8 * MiB) + (size_t)nb * 32 * 2048 + kb * 64; Kd = 2048; } \
        else { r -= 2 * I_PG; const int mat = r / (128 * I_ME); r %= (128 * I_ME); const int le = r / I_ME, l = le >> 6, e = le & 63; r %= I_ME; \
          if (mat < 2) { \
              const int kb = r / 16, nb = r % 16, n0 = nb * 32; \
              src = (mat ? KF(A_W_UP) : KF(A_W_GATE)) + (size_t)le * 2048 * 512 + (size_t)kb * 64 * 512 + n0; N = 512; gain = KF(A_NORM_FFN) + l * DM + kb * 64; \
              const int drow = e * 1024 + (n0 >> 7) * 256 + mat * 128 + (n0 & 127); \
              dst = (bf16_t*)(ws + WS_W_GU + (size_t)l * 256 * MiB + (size_t)drow * 2048 + kb * 64); Kd = 2048; f8 = 1; \
          } else { \
              const int kb = r / 64, nb = r % 64; \
              src = KF(A_W_DOWN) + (size_t)le * 512 * 2048 + (size_t)kb * 64 * 2048 + nb * 32; N = 2048; dst = (bf16_t*)(ws + WS_W_D + (size_t)l * 128 * MiB + (size_t)(e * 2048 + nb * 32) * 512 + kb * 64); Kd = 512; f8 = 1; \
          } } \
        (JOB).src = src; (JOB).gain = gain; (JOB).dst = dst; (JOB).N = N; (JOB).Kd = Kd; (JOB).f8 = f8; } while (0)
    { int it = gw;
      if (it < N_ITEMS) {
        TrJob cur; TR_DECODE(it, cur);
        float v[32]; tr_load(v, cur, F.lane);
        for (;;) {
            const int nit = it + NGW; const bool hn = nit < N_ITEMS;
            TrJob nx = cur; float vn[32];
            if (hn) { TR_DECODE(nit, nx); tr_load(vn, nx, F.lane); }
            tr_store(v, cur, scr, F.lane);
            if (!hn) break;
            cur = nx; it = nit;
#pragma unroll
            for (int i = 0; i < 32; ++i) v[i] = vn[i];
        }
      } }
#undef TR_DECODE
    { const float* xin = KF(A_X);
    for (int row = gw; row < T; row += NGW) {
        const float* xr = xin + (size_t)row * DM + 8 * F.lane; bf16_t* ob = (bf16_t*)(ws + WS_HB) + (size_t)row * DM + 8 * F.lane;
        f32x4 v[8]; float ss = 0.f;
#pragma unroll
        for (int j = 0; j < 4; ++j) { v[2 * j] = *(const f32x4*)(xr + 512 * j); v[2 * j + 1] = *(const f32x4*)(xr + 512 * j + 4); }
#pragma unroll
        for (int j = 0; j < 8; ++j) ss += (v[j][0] * v[j][0] + v[j][1] * v[j][1]) + (v[j][2] * v[j][2] + v[j][3] * v[j][3]);
#pragma unroll
        for (int j = 0; j < 4; ++j) *(u32x4*)(ob + 512 * j) = pack8(v[2 * j], v[2 * j + 1]);
        if (MK_F8_PROJ) {
#pragma unroll
            for (int j = 0; j < 4; ++j) { u32x2 q; q.x = pk4_fp8(v[2 * j][0], v[2 * j][1], v[2 * j][2], v[2 * j][3]); q.y = pk4_fp8(v[2 * j + 1][0], v[2 * j + 1][1], v[2 * j + 1][2], v[2 * j + 1][3]); *(u32x2*)(ws + WS_H8 + (size_t)row * DM + 512 * j + 8 * F.lane) = q; } }
        ss = wave_sum(ss);
        if (F.lane == 0) ((rs_t*)(ws + WS_RSX))[row] = rs_fix(ss);
    } }
    { const float* pin = KF(A_P);
    for (int i = gt; i < 2 * T * PLE / 8; i += NGT) {
        const f32x4 a = *(const f32x4*)(pin + (size_t)i * 8), b = *(const f32x4*)(pin + (size_t)i * 8 + 4);
        *(u32x4*)((bf16_t*)(ws + WS_PB) + (size_t)i * 8) = pack8(a, b);
    } }
    for (int i = gt; i < DM; i += NGT) { const float l = KF(A_LAM)[i]; const float ls = fminf(l, 0.f) - log1pf(__expf(-fabsf(l))); ((float*)(ws + WS_CLAM))[i] = 8.0f * ls; }
    for (int i = gt; i < 2 * 256 * DM; i += NGT) {
        const int l = i / (256 * DM), rem = i % (256 * DM), n = rem / DM, k = rem % DM;
        float v = 0.f;
        if (n < 8) v = KF(A_W_GROUP)[(size_t)l * DM * 8 + (size_t)k * 8 + n];
        else if (n < 72) { const int g = (n - 8) >> 3, e = (n - 8) & 7; v = KF(A_W_EXPERT)[(size_t)l * 8 * DM * 8 + (size_t)g * DM * 8 + (size_t)k * 8 + e]; }
        v *= KF(A_NORM_FFN)[l * DM + k];
        ((bf16_t*)(ws + WS_W_R))[i] = (bf16_t)(cvt_pk_bf16(v, 0.f) & 0xffffu);
    }
}

DI void conv_phase(const Ctx& F, const bf16_t* proj, const float* cw, const float* cb, bf16_t* xc) {
    const int cg = F.tid & 255, sub = F.tid >> 8, ch = cg * 8;
    float w[4][8], b[8];
#pragma unroll
    for (int k = 0; k < 4; ++k)
#pragma unroll
        for (int j = 0; j < 8; ++j) w[k][j] = cw[k * DM + ch + j];
#pragma unroll
    for (int j = 0; j < 8; ++j) b[j] = cb[ch + j];
    for (int item = F.bid; item < T / 64; item += F.G) {
        const int t0 = item * 64 + sub * 32, s0 = t0 & (SEQ - 1);
        float x0[8], x1[8], x2[8];
#pragma unroll
        for (int j = 0; j < 8; ++j) { x0[j] = 0.f; x1[j] = 0.f; x2[j] = 0.f; }
        if (s0 >= 3) { unpack8(*(const u32x4*)(proj + (size_t)(t0 - 3) * 4096 + DM + ch), x0); unpack8(*(const u32x4*)(proj + (size_t)(t0 - 2) * 4096 + DM + ch), x1); unpack8(*(const u32x4*)(proj + (size_t)(t0 - 1) * 4096 + DM + ch), x2); }
#pragma unroll 8
        for (int i = 0; i < 32; ++i) {
            float x3[8]; unpack8(*(const u32x4*)(proj + (size_t)(t0 + i) * 4096 + DM + ch), x3);
            float y[8];
#pragma unroll
            for (int j = 0; j < 8; ++j) { y[j] = b[j] + w[0][j] * x0[j] + w[1][j] * x1[j] + w[2][j] * x2[j] + w[3][j] * x3[j]; x0[j] = x1[j]; x1[j] = x2[j]; x2[j] = x3[j]; }
            *(u32x4*)(xc + (size_t)(t0 + i) * DM + ch) = pack8((f32x4){y[0], y[1], y[2], y[3]}, (f32x4){y[4], y[5], y[6], y[7]});
        }
    }
}

DI void scanA_phase(const Ctx& F, const bf16_t* LA, const bf16_t* U, float* SP, float* SH) {
    const int ch = F.tid * 4;
    for (int item = F.bid; item < T / 128; item += F.G) {
        const size_t base = (size_t)item * 128 * DM + ch;
        float sl[4] = {0.f, 0.f, 0.f, 0.f}, h[4] = {0.f, 0.f, 0.f, 0.f};
#pragma unroll 8
        for (int i = 0; i < 128; ++i) {
            const u32x2 lw = *(const u32x2*)(LA + base + (size_t)i * DM), uw = *(const u32x2*)(U + base + (size_t)i * DM);
            const float l[4] = {bflo(lw.x), bfhi(lw.x), bflo(lw.y), bfhi(lw.y)}, uu[4] = {bflo(uw.x), bfhi(uw.x), bflo(uw.y), bfhi(uw.y)};
#pragma unroll
            for (int j = 0; j < 4; ++j) { sl[j] += l[j]; h[j] = __expf(l[j]) * h[j] + uu[j]; }
        }
        *(f32x4*)(SP + (size_t)item * DM + ch) = (f32x4){sl[0], sl[1], sl[2], sl[3]};
        *(f32x4*)(SH + (size_t)item * DM + ch) = (f32x4){h[0], h[1], h[2], h[3]};
    }
}
DI void scanB_phase(const Ctx& F, const float* SP, const float* SH, float* CIN) {
    const int gw = F.bid * 8 + F.wave, NGW = F.G * 8;
    for (int job = gw; job < NB * DM; job += NGW) {
        const int b = job / DM, ch = job % DM;
        const size_t i0 = ((size_t)(b * 128 + 2 * F.lane)) * DM + ch, i1 = i0 + DM;
        const float Pa = __expf(SP[i0]), Ha = SH[i0], Pb = __expf(SP[i1]), Hb = SH[i1];
        float Pc = Pa * Pb, Hc = Pb * Ha + Hb;
#pragma unroll
        for (int off = 1; off < 64; off <<= 1) {
            const float Pp = __shfl_up(Pc, off), Hp = __shfl_up(Hc, off);
            if (F.lane >= off) { Hc = Pc * Hp + Hc; Pc = Pc * Pp; }
        }
        float ex = __shfl_up(Hc, 1); if (F.lane == 0) ex = 0.f;
        CIN[i0] = ex; CIN[i1] = Pa * ex + Ha;
    }
}
DI float gelu_tanh(float x) { const float z = 0.7978845608028654f * (x + 0.044715f * x * x * x); const float e = __expf(2.0f * z); const float th = 1.0f - 2.0f / (e + 1.0f); return 0.5f * x * (1.0f + th); }
template <bool F8> DI void scanC_phase(const Ctx& F, const bf16_t* LA, const bf16_t* U, const bf16_t* proj, const float* CIN, bf16_t* Y) {
    const int ch = F.tid * 4;
    for (int item = F.bid; item < T / 128; item += F.G) {
        const size_t base = (size_t)item * 128 * DM + ch;
        const f32x4 c = *(const f32x4*)(CIN + (size_t)item * DM + ch);
        float h[4] = {c[0], c[1], c[2], c[3]};
#pragma unroll 8
        for (int i = 0; i < 128; ++i) {
            const u32x2 lw = *(const u32x2*)(LA + base + (size_t)i * DM), uw = *(const u32x2*)(U + base + (size_t)i * DM);
            const u32x2 gw = *(const u32x2*)(proj + ((size_t)item * 128 + i) * 4096 + ch);
            const float l[4] = {bflo(lw.x), bfhi(lw.x), bflo(lw.y), bfhi(lw.y)}, uu[4] = {bflo(uw.x), bfhi(uw.x), bflo(uw.y), bfhi(uw.y)}, gg[4] = {bflo(gw.x), bfhi(gw.x), bflo(gw.y), bfhi(gw.y)};
            float y[4];
#pragma unroll
            for (int j = 0; j < 4; ++j) { h[j] = __expf(l[j]) * h[j] + uu[j]; y[j] = gelu_tanh(gg[j]) * h[j]; }
            if constexpr (F8) *(unsigned*)((unsigned char*)Y + base + (size_t)i * DM) = pk4_fp8(y[0] * 8.f, y[1] * 8.f, y[2] * 8.f, y[3] * 8.f);
            else { u32x2 o; o.x = cvt_pk_bf16(y[0], y[1]); o.y = cvt_pk_bf16(y[2], y[3]); *(u32x2*)(Y + base + (size_t)i * DM) = o; }
        }
    }
}

DI void route_phase(const Ctx& F, const float* logits, const float* b_group, const float* b_expert, unsigned* gcount, int* slot_aid, float* slot_gate) {
    LAS unsigned* hist = (LAS unsigned*)(F.lds + MISC_OFF + MO_HIST); LAS unsigned* base = hist + 64;
    for (int blk = F.bid; blk < T / 128; blk += F.G) {
        if (F.tid < 64) hist[F.tid] = 0u;
        __syncthreads();
        const int t = blk * 128 + F.tid;
        int e0 = 0, e1 = 0; float g0 = 0.f, g1 = 0.f; unsigned r0 = 0u, r1 = 0u;
        if (F.tid < 128) {
            const float* lp = logits + (size_t)t * 128;
            const f32x4 a = *(const f32x4*)lp, b = *(const f32x4*)(lp + 4);
            float lg[8] = {a[0], a[1], a[2], a[3], b[0], b[1], b[2], b[3]};
            int gi = 0; float gm = -3.0e38f;
#pragma unroll
            for (int j = 0; j < 8; ++j) { lg[j] += b_group[j]; if (lg[j] > gm) { gm = lg[j]; gi = j; } }
            float den = 0.f;
#pragma unroll
            for (int j = 0; j < 8; ++j) den += __expf(lg[j] - gm);
            const float ptop = 1.0f / den;
            const f32x4 c = *(const f32x4*)(lp + 8 + gi * 8), d = *(const f32x4*)(lp + 12 + gi * 8);
            float le[8] = {c[0], c[1], c[2], c[3], d[0], d[1], d[2], d[3]};
            int i1 = 0; float v1 = -3.0e38f;
#pragma unroll
            for (int j = 0; j < 8; ++j) { le[j] += b_expert[gi * 8 + j]; if (le[j] > v1) { v1 = le[j]; i1 = j; } }
            int i2 = 0; float v2 = -3.0e38f;
#pragma unroll
            for (int j = 0; j < 8; ++j) { if (j != i1 && le[j] > v2) { v2 = le[j]; i2 = j; } }
            const float w1 = 1.0f / (1.0f + __expf(v2 - v1)), w2 = 1.0f - w1;
            e0 = gi * 8 + i1; e1 = gi * 8 + i2; g0 = ptop * w1; g1 = ptop * w2;
            r0 = __hip_atomic_fetch_add(hist + e0, 1u, __ATOMIC_RELAXED, __HIP_MEMORY_SCOPE_WORKGROUP);
            r1 = __hip_atomic_fetch_add(hist + e1, 1u, __ATOMIC_RELAXED, __HIP_MEMORY_SCOPE_WORKGROUP);
        }
        __syncthreads();
        if (F.tid < 64) { const unsigned c = hist[F.tid]; base[F.tid] = c ? __hip_atomic_fetch_add(gcount + F.tid, c, __ATOMIC_RELAXED, __HIP_MEMORY_SCOPE_AGENT) : 0u; }
        __syncthreads();
        if (F.tid < 128) {
            const unsigned p0 = base[e0] + r0, p1 = base[e1] + r1;
            slot_aid[e0 * SLOTCAP + p0] = 2 * t; slot_gate[e0 * SLOTCAP + p0] = g0;
            slot_aid[e1 * SLOTCAP + p1] = 2 * t + 1; slot_gate[e1 * SLOTCAP + p1] = g1;
        }
        __syncthreads();
    }
}
DI void moe_tables(const Ctx& F, unsigned* gcount) {
    LAS int* cnt = (LAS int*)(F.lds + MISC_OFF + MO_CNT); LAS int* mtpre = (LAS int*)(F.lds + MISC_OFF + MO_MTPRE); LAS unsigned char* t2e = F.lds + MISC_OFF + MO_T2E;
    if (F.tid < 64) cnt[F.tid] = (int)__hip_atomic_load(gcount + F.tid, __ATOMIC_RELAXED, __HIP_MEMORY_SCOPE_AGENT);
    __syncthreads();
    if (F.tid == 0) { int s = 0; for (int e = 0; e < 64; ++e) { mtpre[e] = s; s += (cnt[e] + 255) >> 8; } mtpre[64] = s; }
    __syncthreads();
    if (F.tid < 64) { const int a = mtpre[F.tid], b = mtpre[F.tid + 1]; for (int m = a; m < b && m < 384; ++m) t2e[m] = (unsigned char)F.tid; }
    __syncthreads();
}

template <bool F8> DI void combine_phase(const Ctx& F, const unsigned char* yb, bf16_t* hb, unsigned char* h8) {
    const int gw = F.bid * 8 + F.wave, NGW = F.G * 8;
    for (int row = gw; row < T; row += NGW) {
        const unsigned char* y0 = yb + (size_t)(2 * row) * DM + 8 * F.lane; const unsigned char* y1 = y0 + DM; bf16_t* hrow = hb + (size_t)row * DM + 8 * F.lane;
        u32x4 hw[4]; u32x2 a0[4], a1[4];
#pragma unroll
        for (int j = 0; j < 4; ++j) { hw[j] = *(const u32x4*)(hrow + 512 * j); a0[j] = *(const u32x2*)(y0 + 512 * j); a1[j] = *(const u32x2*)(y1 + 512 * j); }
#pragma unroll
        for (int j = 0; j < 4; ++j) {
            float h[8], v0[8], v1[8]; unpack8(hw[j], h); unpack8_fp8(a0[j], v0); unpack8_fp8(a1[j], v1);
#pragma unroll
            for (int k = 0; k < 8; ++k) h[k] += (v0[k] + v1[k]) * (1.0f / 16.0f);
            *(u32x4*)(hrow + 512 * j) = pack8((f32x4){h[0], h[1], h[2], h[3]}, (f32x4){h[4], h[5], h[6], h[7]});
            if constexpr (F8) { u32x2 q; q.x = pk4_fp8(h[0], h[1], h[2], h[3]); q.y = pk4_fp8(h[4], h[5], h[6], h[7]); *(u32x2*)(h8 + (size_t)row * DM + 512 * j + 8 * F.lane) = q; }
        }
    }
}
DI void finish_phase(const Ctx& F, float* out, const bf16_t* eg, const rs_t* rowss_eg, const float* gain, bf16_t* hb, unsigned char* h8, rs_t* rowss_next, bool last) {
    const int gw = F.bid * 8 + F.wave, NGW = F.G * 8;
    float gn[4][8];
#pragma unroll
    for (int j = 0; j < 4; ++j)
#pragma unroll
        for (int k = 0; k < 8; ++k) gn[j][k] = gain[512 * j + 8 * F.lane + k];
    for (int row = gw; row < T; row += NGW) {
        float* orow = out + (size_t)row * DM + 8 * F.lane; const bf16_t* erow = eg + (size_t)row * DM + 8 * F.lane; bf16_t* hrow = hb + (size_t)row * DM + 8 * F.lane;
        u32x4 hw[4], ew[4];
#pragma unroll
        for (int j = 0; j < 4; ++j) { hw[j] = *(const u32x4*)(hrow + 512 * j); ew[j] = *(const u32x4*)(erow + 512 * j); }
        const float rs = rs_rstd(rowss_eg[row]);
        float ss = 0.f;
#pragma unroll
        for (int j = 0; j < 4; ++j) {
            float h[8], ev[8]; unpack8(hw[j], h); unpack8(ew[j], ev);
#pragma unroll
            for (int k = 0; k < 8; ++k) { h[k] += ev[k] * rs * gn[j][k]; ss += h[k] * h[k]; }
            if (last) { *(f32x4*)(orow + 512 * j) = (f32x4){h[0], h[1], h[2], h[3]}; *(f32x4*)(orow + 512 * j + 4) = (f32x4){h[4], h[5], h[6], h[7]}; }
            else { *(u32x4*)(hrow + 512 * j) = pack8((f32x4){h[0], h[1], h[2], h[3]}, (f32x4){h[4], h[5], h[6], h[7]});
                   u32x2 q; q.x = pk4_fp8(h[0], h[1], h[2], h[3]); q.y = pk4_fp8(h[4], h[5], h[6], h[7]); *(u32x2*)(h8 + (size_t)row * DM + 512 * j + 8 * F.lane) = q; }
        }
        if (!last) { ss = wave_sum(ss); if (F.lane == 0) rowss_next[row] = rs_fix(ss); }
    }
}

DI int k_off(int row, int chunk) { return row * 256 + ((chunk ^ (row & 15)) << 4); }
DI int v_off(int row, int chunk) { return row * 256 + ((chunk ^ ((row & 7) << 1)) << 4); }
struct AUnit { int g, head, d, n; size_t tok0, prow0; };
DI void attn_decode_seg(int sid, int u, AUnit& U) {
    const int g = sid >> 8, idx = sid & 255, head = idx & 7, rest = idx >> 3;
    const int dsh = 2 * g, nsc = 16 >> dsh, chain = rest / nsc, b = chain >> dsh, r = chain & ((1 << dsh) - 1);
    U.g = g; U.head = head; U.d = 1 << dsh; U.n = (rest % nsc) * 8 + u; U.tok0 = (size_t)b * SEQ + r;
    U.prow0 = (size_t)b * SEQ + (size_t)r * (SEQ >> dsh);
}
#define ATT_PLANE(U_, s_) (qkv + (((size_t)((U_).g * 3 + (s_)) * 8 + (U_).head) * T) * HD)
#define ATT_LOADS(U_, first_) do { \
    _Pragma("unroll") for (int ps = 0; ps < 8; ++ps) { if ((first_) || ps >= 4) { const int j_ = 128 * ((U_).n - 1) + ps * 32 + rowi; kraw[ps] = (u32x2){0u, 0u}; vraw[ps] = (u32x2){0u, 0u}; kpos[ps] = 0; \
        if (j_ >= 0) { const size_t ro_ = ((U_).prow0 + (size_t)j_) * HD + chunk * 8; kraw[ps] = *(const u32x2*)(ATT_PLANE(U_, 1) + ro_); vraw[ps] = *(const u32x2*)(ATT_PLANE(U_, 2) + ro_); \
                       kpos[ps] = positions[(U_).tok0 + (size_t)j_ * (U_).d]; } } } \
    { const int jq_ = 128 * (U_).n + 16 * w + q16; \
      _Pragma("unroll") for (int dk = 0; dk < 4; ++dk) qraw[dk] = *(const u32x2*)(ATT_PLANE(U_, 0) + ((U_).prow0 + (size_t)jq_) * HD + dk * 32 + 8 * gq); \
      qpos = positions[(U_).tok0 + (size_t)jq_ * (U_).d]; } \
    } while (0)
DI float rope_rev_const(int i) { return __builtin_amdgcn_exp2f(-(float)i * 0.20762050593046014f) * 0.15915494309189535f; }
DI void attn_phase(const Ctx& F, const unsigned char* qkv, const float* q_gain, const float* k_gain, const int* positions, bf16_t* og, float* lse) {
    LAS unsigned char* Ks = F.lds; LAS unsigned char* Vs = F.lds + 65536;
    const int lane = F.lane, w = F.wave, q16 = lane & 15, gq = lane >> 4;
    const int chunk = F.tid & 15, rowi = F.tid >> 4, ci = 8 * (chunk & 7);
    const int nseg = (768 - F.bid + F.G - 1) / F.G, nsteps = nseg * 8;
    if (F.bid >= 768) return;
    int st = 0;
    AUnit U, Un; attn_decode_seg(F.bid, 0, U);
    u32x2 kraw[8], vraw[8], qraw[4]; int kpos[8], qpos;
#pragma unroll
    for (int ps = 0; ps < 8; ++ps) { kraw[ps] = (u32x2){0u, 0u}; vraw[ps] = (u32x2){0u, 0u}; kpos[ps] = 0; }
    ATT_LOADS(U, true);
    for (;;) {
        const int g = U.g, head = U.head, n = U.n;
        const bool first = (st & 7) == 0;
        {
            float kg[8]; { const f32x4 a = *(const f32x4*)(k_gain + g * HD + 8 * chunk), c = *(const f32x4*)(k_gain + g * HD + 8 * chunk + 4);
#pragma unroll
                for (int k = 0; k < 4; ++k) { kg[k] = a[k]; kg[4 + k] = c[k]; } }
            float kc[8];
#pragma unroll
            for (int k = 0; k < 8; ++k) kc[k] = rope_rev_const(ci + k);
#pragma unroll
            for (int ps = 0; ps < 8; ++ps) {
                if (first || ps >= 4) {
                    const int krow = ps * 32 + rowi;
                    if (!first) {
                        const u32x4 tk = *(const LAS u32x4*)(Ks + k_off(krow, chunk)), tv = *(const LAS u32x4*)(Vs + v_off(krow, chunk));
                        *(LAS u32x4*)(Ks + k_off(krow - 128, chunk)) = tk; *(LAS u32x4*)(Vs + v_off(krow - 128, chunk)) = tv; }
                    float v[8]; unpack8_fp8(kraw[ps], v);
                    float ss = 0.f;
#pragma unroll
                    for (int k = 0; k < 8; ++k) ss += v[k] * v[k];
                    ss = row16_sum(ss);
                    const float rs = __builtin_amdgcn_rsqf(ss * (1.0f / HD) + EPS);
                    float pv[8], o[8];
#pragma unroll
                    for (int k = 0; k < 8; ++k) v[k] = v[k] * rs * kg[k];
#pragma unroll
                    for (int k = 0; k < 8; ++k) pv[k] = row16_xor8(v[k]);
                    const float fp = (float)kpos[ps];
#pragma unroll
                    for (int k = 0; k < 8; ++k) { const float rev = fp * kc[k], fr = rev - __builtin_rintf(rev); const float c = __builtin_amdgcn_cosf(fr), sn = __builtin_amdgcn_sinf(fr);
                        o[k] = (chunk < 8) ? (v[k] * c - pv[k] * sn) : (v[k] * c + pv[k] * sn); }
                    *(LAS u32x4*)(Ks + k_off(krow, chunk)) = pack8((f32x4){o[0], o[1], o[2], o[3]}, (f32x4){o[4], o[5], o[6], o[7]});
                    float vv[8]; unpack8_fp8(vraw[ps], vv);
                    *(LAS u32x4*)(Vs + v_off(krow, chunk)) = pack8((f32x4){vv[0], vv[1], vv[2], vv[3]}, (f32x4){vv[4], vv[5], vv[6], vv[7]});
                }
            }
        }
        const size_t pq = U.prow0 + (size_t)(128 * n + 16 * w + q16);
        bf16x8 qf[4];
        {
            float qv[4][8];
#pragma unroll
            for (int dk = 0; dk < 4; ++dk) unpack8_fp8(qraw[dk], qv[dk]);
            float ss = 0.f;
#pragma unroll
            for (int dk = 0; dk < 4; ++dk)
#pragma unroll
                for (int k = 0; k < 8; ++k) ss += qv[dk][k] * qv[dk][k];
            ss += __shfl_xor(ss, 16); ss += __shfl_xor(ss, 32);
            const float rs = __builtin_amdgcn_rsqf(ss * (1.0f / HD) + EPS);
#pragma unroll
            for (int dk = 0; dk < 4; ++dk) { const f32x4 ga = *(const f32x4*)(q_gain + g * HD + dk * 32 + 8 * gq), gb = *(const f32x4*)(q_gain + g * HD + dk * 32 + 8 * gq + 4);
#pragma unroll
                for (int k = 0; k < 4; ++k) { qv[dk][k] *= rs * ga[k]; qv[dk][4 + k] *= rs * gb[k]; } }
#pragma unroll
            for (int dk = 0; dk < 2; ++dk) {
                const float fp = (float)qpos;
#pragma unroll
                for (int k = 0; k < 8; ++k) { const float rev = fp * rope_rev_const(32 * dk + 8 * gq + k), fr = rev - __builtin_rintf(rev); const float c = __builtin_amdgcn_cosf(fr), sn = __builtin_amdgcn_sinf(fr);
                    const float t1 = qv[dk][k], t2 = qv[dk + 2][k]; qv[dk][k] = t1 * c - t2 * sn; qv[dk + 2][k] = t2 * c + t1 * sn; }
            }
#pragma unroll
            for (int dk = 0; dk < 4; ++dk) qf[dk] = __builtin_bit_cast(bf16x8, pack8((f32x4){qv[dk][0], qv[dk][1], qv[dk][2], qv[dk][3]}, (f32x4){qv[dk][4], qv[dk][5], qv[dk][6], qv[dk][7]}));
        }
        asm volatile("" : "+v"(qf[0]), "+v"(qf[1]), "+v"(qf[2]), "+v"(qf[3]) :: "memory");
        __syncthreads();
        const int nst = st + 1; const bool hn = nst < nsteps;
        if (hn) { attn_decode_seg(F.bid + (nst >> 3) * F.G, nst & 7, Un); const bool nfirst = (nst & 7) == 0; ATT_LOADS(Un, nfirst); }
        __builtin_amdgcn_sched_barrier(0);
        f32x4 s[9];
#pragma unroll
        for (int i = 0; i < 9; ++i) {
            f32x4 a = {0.f, 0.f, 0.f, 0.f};
            const int krow = 16 * (w + i) + q16;
#pragma unroll
            for (int dk = 0; dk < 4; ++dk) { const bf16x8 kf = *(const LAS bf16x8*)(Ks + k_off(krow, 4 * dk + gq)); a = __builtin_amdgcn_mfma_f32_16x16x32_bf16(kf, qf[dk], a, 0, 0, 0); }
            s[i] = a;
        }
        constexpr float C2 = 0.08838834764831845f * 1.4426950408889634f;
        float mx = -3.0e38f;
#pragma unroll
        for (int i = 0; i < 9; ++i)
#pragma unroll
            for (int rg = 0; rg < 4; ++rg) {
                const int dlt = 16 * i + 4 * gq + rg - q16;
                bool ok = (dlt >= 0) && (dlt <= 128);
                if (n == 0 && (w + i) < 8) ok = false;
                const float v = ok ? s[i][rg] * C2 : -1.0e30f;
                s[i][rg] = v; mx = fmaxf(mx, v);
            }
        mx = fmaxf(mx, __shfl_xor(mx, 16)); mx = fmaxf(mx, __shfl_xor(mx, 32));
        float den = 0.f;
#pragma unroll
        for (int i = 0; i < 9; ++i)
#pragma unroll
            for (int rg = 0; rg < 4; ++rg) { const float p = __builtin_amdgcn_exp2f(s[i][rg] - mx); s[i][rg] = p; den += p; }
        den += __shfl_xor(den, 16); den += __shfl_xor(den, 32);
        f32x4 o[8];
#pragma unroll
        for (int db = 0; db < 8; ++db) o[db] = (f32x4){0.f, 0.f, 0.f, 0.f};
#pragma unroll
        for (int t5 = 0; t5 < 5; ++t5) {
            const int i0 = 2 * t5, i1 = (t5 < 4) ? 2 * t5 + 1 : 8;
            const f32x4 p0 = s[i0], p1 = (t5 < 4) ? s[i1] : (f32x4){0.f, 0.f, 0.f, 0.f};
            const u32x4 pw = pack8(p0, p1); const bf16x8 pb = __builtin_bit_cast(bf16x8, pw);
            const int row0 = 16 * (w + i0) + 4 * gq + (q16 >> 2), row1 = 16 * (w + i1) + 4 * gq + (q16 >> 2);
#pragma unroll
            for (int db = 0; db < 8; ++db) {
                const int vch = 2 * db + ((q16 & 3) >> 1), sub8 = (q16 & 1) * 8;
                const s16x4 lo = __builtin_amdgcn_ds_read_tr16_b64_v4i16((LAS s16x4*)(Vs + v_off(row0, vch) + sub8));
                const s16x4 hi = __builtin_amdgcn_ds_read_tr16_b64_v4i16((LAS s16x4*)(Vs + v_off(row1, vch) + sub8));
                const bf16x8 vf = __builtin_shufflevector(lo, hi, 0, 1, 2, 3, 4, 5, 6, 7);
                o[db] = __builtin_amdgcn_mfma_f32_16x16x32_bf16(vf, pb, o[db], 0, 0, 0);
            }
        }
        const float inv = 1.0f / den;
        bf16_t* orow = og + (((size_t)g * NHEAD + head) * T + pq) * HD + 4 * gq;
#pragma unroll
        for (int db = 0; db < 8; ++db) { u32x2 ow; ow.x = cvt_pk_bf16(o[db][0] * inv, o[db][1] * inv); ow.y = cvt_pk_bf16(o[db][2] * inv, o[db][3] * inv); *(u32x2*)(orow + 16 * db) = ow; }
        if (gq == 0) lse[((size_t)g * NHEAD + head) * T + pq] = (mx + __builtin_amdgcn_logf(den)) * 0.6931471805599453f;
        __syncthreads();
        if (!hn) break;
        U = Un; st = nst;
    }
}
#undef ATT_LOADS
#undef ATT_PLANE
template <bool F8> DI void merge_phase(const Ctx& F, const bf16_t* og, const float* lse, bf16_t* ob) {
    const int gt = F.bid * 512 + F.tid, NGT = F.G * 512;
    for (int i = gt; i < T * 128; i += NGT) {
        const int t = i >> 7, c8 = i & 127, head = c8 >> 4;
        const size_t p0 = g8::qkv_plane_row(t, 0), p1 = g8::qkv_plane_row(t, 2), p2 = g8::qkv_plane_row(t, 4);
        const float l0 = lse[((size_t)0 * NHEAD + head) * T + p0], l1 = lse[((size_t)1 * NHEAD + head) * T + p1], l2 = lse[((size_t)2 * NHEAD + head) * T + p2];
        const float m = fmaxf(l0, fmaxf(l1, l2));
        float w0 = __expf(l0 - m), w1 = __expf(l1 - m), w2 = __expf(l2 - m); const float inv = 1.0f / (w0 + w1 + w2); w0 *= inv; w1 *= inv; w2 *= inv;
        float a[8], b[8], c[8];
        const int dd = (c8 & 15) * 8;
        unpack8(*(const u32x4*)(og + (((size_t)0 * NHEAD + head) * T + p0) * HD + dd), a); unpack8(*(const u32x4*)(og + (((size_t)1 * NHEAD + head) * T + p1) * HD + dd), b); unpack8(*(const u32x4*)(og + (((size_t)2 * NHEAD + head) * T + p2) * HD + dd), c);
        float o[8];
#pragma unroll
        for (int k = 0; k < 8; ++k) o[k] = w0 * a[k] + w1 * b[k] + w2 * c[k];
        if constexpr (F8) { u32x2 q; q.x = pk4_fp8(o[0] * 16.f, o[1] * 16.f, o[2] * 16.f, o[3] * 16.f); q.y = pk4_fp8(o[4] * 16.f, o[5] * 16.f, o[6] * 16.f, o[7] * 16.f); *(u32x2*)((unsigned char*)ob + (size_t)t * 1024 + c8 * 8) = q; }
        else *(u32x4*)(ob + (size_t)t * 1024 + c8 * 8) = pack8((f32x4){o[0], o[1], o[2], o[3]}, (f32x4){o[4], o[5], o[6], o[7]});
    }
}

struct Args { const void* in[28]; float* out; unsigned char* ws; int ph_lo, ph_hi; };

__global__ void __launch_bounds__(512, 2) mk_fwd(Args args) {
    extern __shared__ __attribute__((aligned(16))) unsigned char lds_raw[];
    Ctx F; F.lds = (LAS unsigned char*)lds_raw; F.G = gridDim.x; F.bid = blockIdx.x;
    int wave_s = __builtin_amdgcn_readfirstlane((int)threadIdx.x >> 6); asm volatile("" : "+s"(wave_s));
#define RF() do { int l_ = (int)__builtin_amdgcn_mbcnt_hi(~0u, __builtin_amdgcn_mbcnt_lo(~0u, 0u)); asm volatile("" : "+v"(l_)); F.lane = l_; F.wave = wave_s; F.tid = wave_s * 64 + l_; } while (0)
    RF();
    unsigned char* ws = (unsigned char*)karg_ptr(A_WS);
    unsigned* ctl = (unsigned*)(ws + WS_CTL);
    for (int u = F.tid; u < (LDS_BYTES - MISC_OFF) / 4; u += 512) ((LAS unsigned*)(F.lds + MISC_OFF))[u] = 0u;
    __syncthreads();
    XcdBarrier bar; bar.bar = ctl + CW_BAR; bar.x = 0; bar.st = nullptr;
    if (N_LAUNCHES == 1) bar = xcd_barrier_post(ctl + CW_BAR, (volatile LAS unsigned*)(F.lds + MISC_OFF + MO_BARW), F.tid);
    const int lo = args.ph_lo, hi = args.ph_hi;
#define IN(k) (lo <= (k) && (k) < hi)
#define SEAM(k) do { if (IN((k) + 1)) { RF(); if (N_LAUNCHES == 1) xcd_barrier(bar, F.tid); } } while (0)

    bf16_t* HB = (bf16_t*)(ws + WS_HB);
    rs_t* rowss_acc = (rs_t*)(ctl + CW_ROWSS);
    rs_t* RSX = (rs_t*)(ws + WS_RSX); rs_t* RSH3 = (rs_t*)(ws + WS_RSH3);
    LAS unsigned char* ring = F.lds;

    if (IN(0)) { RF(); for (int rep = 0; rep < ((MK_DUP & 1) ? 2 : 1); ++rep) p0_prologue(F, ws); SEAM(0); }
    if (IN(1)) { RF();
        constexpr bool F8 = MK_F8_PROJ != 0; constexpr unsigned LD = F8 ? DM : DM * 2;
        g8::StaticSched S; S.init(F8 ? (const void*)(ws + WS_H8) : (const void*)HB, LD, ws + WS_W_IN, LD, T / 256, 4096 / 256, F.G, F.bid);
        g8::EpiBf16ScaleT<F8> E{(bf16_t*)(ws + WS_PROJ), 4096, RSX, F8 ? 1.0f / 64.0f : 1.0f};
        for (int rep = 0; rep < ((MK_DUP & 1024) ? 2 : 1); ++rep) g8::gemm_phase(ring, F.tid, F8 ? DM / 2 : DM, LD, LD, S, E);
        SEAM(1);
    }
    if (IN(2)) { RF(); for (int rep = 0; rep < ((MK_DUP & 512) ? 2 : 1); ++rep) conv_phase(F, (const bf16_t*)(ws + WS_PROJ), KF(A_CONV_W), KF(A_CONV_B), (bf16_t*)(ws + WS_XC)); SEAM(2); }
    if (IN(3)) { RF();
        g8::GateSched S; S.init(ws + WS_XC, ws + WS_W_G, F.G, F.bid);
        g8::EpiGates E{(const bf16_t*)(ws + WS_XC), KF(A_B_RG), KF(A_B_IG), (const float*)(ws + WS_CLAM), (bf16_t*)(ws + WS_LA), (bf16_t*)(ws + WS_U)};
        for (int rep = 0; rep < ((MK_DUP & 4096) ? 2 : 1); ++rep) g8::gemm_phase(ring, F.tid, 256, DM * 2, 256 * 2, S, E);
        SEAM(3);
    }
    if (IN(4)) { RF(); for (int rep = 0; rep < ((MK_DUP & 512) ? 2 : 1); ++rep) scanA_phase(F, (const bf16_t*)(ws + WS_LA), (const bf16_t*)(ws + WS_U), (float*)(ws + WS_SP), (float*)(ws + WS_SH)); SEAM(4); }
    if (IN(5)) { RF(); for (int rep = 0; rep < ((MK_DUP & 512) ? 2 : 1); ++rep) scanB_phase(F, (const float*)(ws + WS_SP), (const float*)(ws + WS_SH), (float*)(ws + WS_CIN)); SEAM(5); }
    if (IN(6)) { RF(); for (int rep = 0; rep < ((MK_DUP & 512) ? 2 : 1); ++rep) scanC_phase<MK_F8_WOUT != 0>(F, (const bf16_t*)(ws + WS_LA), (const bf16_t*)(ws + WS_U), (const bf16_t*)(ws + WS_PROJ), (const float*)(ws + WS_CIN), (bf16_t*)(ws + WS_XC)); SEAM(6); }
    if (IN(7)) { RF();
        constexpr bool F8 = MK_F8_WOUT != 0; constexpr unsigned LD = F8 ? DM : DM * 2;
        g8::StaticSched S; S.init(ws + WS_XC, LD, ws + WS_W_OUT, LD, T / 256, DM / 256, F.G, F.bid);
        g8::EpiResidT<F8> E{HB, ws + WS_H8, rowss_acc + 0 * T, F8 ? 1.0f / (64.0f * 8.0f) : 1.0f};
        g8::gemm_phase(ring, F.tid, F8 ? DM / 2 : DM, LD, LD, S, E); SEAM(7);
    }
#define MOE_LAYER(PH, L, RS_H, RS_EG, RS_NEXT, LAST) \
    if (IN(PH)) { RF();   \
        { g8::StaticSched S; S.init(HB, DM * 2, ws + WS_W_R + (size_t)(L) * MiB, DM * 2, T / 256, 1, F.G, F.bid); \
          g8::EpiLogits E{(float*)(ws + WS_LOGITS), RS_H}; g8::gemm_phase(ring, F.tid, DM, DM * 2, DM * 2, S, E); } \
        { g8::StaticSched S; S.init(ws + WS_PB + (size_t)(L) * T * PLE * 2, PLE * 2, ws + WS_W_PP + (size_t)(L) * MiB, PLE * 2, T / 256, DM / 256, F.G, F.bid); \
          g8::EpiBf16Scale E{(bf16_t*)(ws + WS_EG), DM, nullptr, 1.0f}; g8::gemm_phase(ring, F.tid, PLE, PLE * 2, PLE * 2, S, E); } \
        SEAM(PH); } \
    if (IN((PH) + 1)) { RF(); route_phase(F, (const float*)(ws + WS_LOGITS), KF(A_B_GROUP) + (L) * 8, KF(A_B_EXPERT) + (L) * 64, ctl + CW_CNT + (L) * 64, (int*)(ws + WS_SLOT_AID), (float*)(ws + WS_SLOT_GATE)); SEAM((PH) + 1); } \
    if (IN((PH) + 2)) { RF(); moe_tables(F, ctl + CW_CNT + (L) * 64); \
        g8::MoeSched<4, true> S; S.init(ws + WS_H8, DM, ws + WS_W_GU + (size_t)(L) * 256 * MiB, DM, (size_t)1024 * DM, (const int*)(ws + WS_SLOT_AID), F.lds + MISC_OFF, F.G, F.bid); \
        g8::EpiGU E{ws + WS_HID, (const int*)(ws + WS_SLOT_AID), RS_H}; for (int rep = 0; rep < ((MK_DUP & 8) ? 2 : 1); ++rep) g8::gemm_phase(ring, F.tid, DM / 2, DM, DM, S, E); SEAM((PH) + 2); } \
    if (IN((PH) + 3)) { RF(); moe_tables(F, ctl + CW_CNT + (L) * 64); \
        g8::MoeSched<8, false> S; S.init(ws + WS_HID, DEXP, ws + WS_W_D + (size_t)(L) * 128 * MiB, DEXP, (size_t)DM * DEXP, (const int*)(ws + WS_SLOT_AID), F.lds + MISC_OFF, F.G, F.bid); \
        g8::EpiDown E{ws + WS_YB, (const int*)(ws + WS_SLOT_AID), (const float*)(ws + WS_SLOT_GATE)}; for (int rep = 0; rep < ((MK_DUP & 16) ? 2 : 1); ++rep) g8::gemm_phase(ring, F.tid, DEXP / 2, DEXP, DEXP, S, E); SEAM((PH) + 3); } \
    if (IN((PH) + 4)) { RF(); combine_phase<MK_F8_PLEG != 0>(F, ws + WS_YB, HB, ws + WS_H8); SEAM((PH) + 4); } \
    if (IN((PH) + 5)) { RF(); constexpr bool F8 = MK_F8_PLEG != 0; constexpr unsigned LD = F8 ? DM : DM * 2; \
        g8::StaticSched S; S.init(F8 ? (const void*)(ws + WS_H8) : (const void*)HB, LD, ws + WS_W_PG + (size_t)(L) * 8 * MiB, LD, T / 256, DM / 256, F.G, F.bid); \
        g8::EpiPleGT<F8> E{(bf16_t*)(ws + WS_EG), RS_EG, F8 ? 1.0f / 64.0f : 1.0f}; g8::gemm_phase(ring, F.tid, F8 ? DM / 2 : DM, LD, LD, S, E); SEAM((PH) + 5); } \
    if (IN((PH) + 6)) { RF(); finish_phase(F, (float*)karg_ptr(A_OUT), (const bf16_t*)(ws + WS_EG), RS_EG, KF(A_PLE_NORM) + (L) * DM, HB, ws + WS_H8, RS_NEXT, LAST); SEAM((PH) + 6); }

    MOE_LAYER(8, 0, rowss_acc + 0 * T, rowss_acc + 1 * T, RSH3, false)
    if (IN(15)) { RF();
        g8::StaticSched S; S.init(ws + WS_H8, DM, ws + WS_W_QKV, DM, T / 256, NQKV / 256, F.G, F.bid);
        g8::EpiQkvPlanes E{ws + WS_QKV, RSH3, 1.0f / 64.0f};
        for (int rep = 0; rep < ((MK_DUP & 2) ? 2 : 1); ++rep) g8::gemm_phase(ring, F.tid, DM / 2, DM, DM, S, E);
        SEAM(15);
    }
    if (IN(17)) { RF(); for (int rep = 0; rep < ((MK_DUP & 4) ? 2 : 1); ++rep) attn_phase(F, ws + WS_QKV, KF(A_Q_GAIN), KF(A_K_GAIN), (const int*)karg_ptr(A_POS), (bf16_t*)(ws + WS_OG), (float*)(ws + WS_LSE)); SEAM(17); }
    if (IN(18)) { RF(); merge_phase<MK_F8_WO != 0>(F, (const bf16_t*)(ws + WS_OG), (const float*)(ws + WS_LSE), (bf16_t*)(ws + WS_OB)); SEAM(18); }
    if (IN(19)) { RF();
        constexpr bool F8 = MK_F8_WO != 0; constexpr unsigned LD = F8 ? 1024 : 2048;
        g8::StaticSched S; S.init(ws + WS_OB, LD, ws + WS_W_O, LD, T / 256, DM / 256, F.G, F.bid);
        g8::EpiResidT<F8> E{HB, ws + WS_H8, rowss_acc + 2 * T, F8 ? 1.0f / (64.0f * 16.0f) : 1.0f};
        g8::gemm_phase(ring, F.tid, F8 ? 512 : 1024, LD, LD, S, E); SEAM(19);
    }
    MOE_LAYER(20, 1, rowss_acc + 2 * T, rowss_acc + 3 * T, RSH3, true)
#undef IN
#undef SEAM
}

extern "C" void kernel_launch(void* const* d_in, const int* in_sizes, int n_in, void* d_out, int out_size, void* d_ws, size_t ws_size, hipStream_t stream) {
    static int grid = 0;
    if (grid == 0) {
        if (n_in != 28 || in_sizes[0] != T * DM || out_size != T * DM || ws_size < WS_END) {
            fprintf(stderr, "kernel_launch: unexpected problem (n_in %d, in0 %d, out %d, ws %zu < %zu); nothing launched\n", n_in, n_in > 0 ? in_sizes[0] : -1, out_size, ws_size, (size_t)WS_END); grid = -1; return; }
        int dev = 0, cus = 0, per_cu = 0;
        if (hipGetDevice(&dev) != hipSuccess || hipDeviceGetAttribute(&cus, hipDeviceAttributeMultiprocessorCount, dev) != hipSuccess) { grid = -1; return; }
        if (hipFuncSetAttribute((const void*)mk_fwd, hipFuncAttributeMaxDynamicSharedMemorySize, LDS_BYTES) != hipSuccess) { fprintf(stderr, "kernel_launch: hipFuncSetAttribute failed\n"); grid = -1; return; }
        if (hipOccupancyMaxActiveBlocksPerMultiprocessor(&per_cu, (const void*)mk_fwd, 512, LDS_BYTES) != hipSuccess || per_cu < 1)
            fprintf(stderr, "kernel_launch: note: occupancy query reports %d workgroups per CU\n", per_cu);
        (void)hipGetLastError();
        grid = cus;
    }
    if (grid < 0) return;
    if (hipMemsetAsync((char*)d_ws + WS_CTL, 0, CTL_ZERO_BYTES, stream) != hipSuccess) { fprintf(stderr, "kernel_launch: memset failed\n"); return; }
    Args a{};
    for (int i = 0; i < 28; ++i) a.in[i] = d_in[i];
    a.out = (float*)d_out; a.ws = (unsigned char*)d_ws;
    if (N_LAUNCHES == 1) {
        a.ph_lo = 0; a.ph_hi = NPH;
        hipLaunchKernelGGL(mk_fwd, dim3(grid), dim3(512), LDS_BYTES, stream, a);
    } else {
        for (int li = 0; li < NPH; ++li) { a.ph_lo = li; a.ph_hi = li + 1; hipLaunchKernelGGL(mk_fwd, dim3(grid), dim3(512), LDS_BYTES, stream, a); }
    }
    const hipError_t le = hipPeekAtLastError();
    if (le != hipSuccess) fprintf(stderr, "kernel_launch: launch failed: %s\n", hipGetErrorName(le));
}
```

```cpp
#include <hip/hip_runtime.h>
#include <cstdio>
#include <cstdint>

#ifndef MK_DUP
#define MK_DUP 0
#endif
#ifndef MK_F8_WOUT
#define MK_F8_WOUT 0
#endif
#ifndef MK_F8_WO
#define MK_F8_WO 1
#endif
#ifndef MK_F8_PROJ
#define MK_F8_PROJ 0
#endif
#ifndef MK_F8_PLEG
#define MK_F8_PLEG 0
#endif
#ifndef MK_N_LAUNCHES
#define MK_N_LAUNCHES 1
#endif

#define DI __device__ __forceinline__
#define LAS __attribute__((address_space(3)))
typedef unsigned short bf16_t;
typedef short bf16x8 __attribute__((ext_vector_type(8)));
typedef short s16x4 __attribute__((ext_vector_type(4)));
typedef float f32x4 __attribute__((ext_vector_type(4)));
typedef unsigned u32x4 __attribute__((ext_vector_type(4)));
typedef unsigned u32x2 __attribute__((ext_vector_type(2)));
typedef int i32x8 __attribute__((ext_vector_type(8)));
typedef short s16x16 __attribute__((ext_vector_type(16)));

constexpr int NB = 2, SEQ = 16384, T = NB * SEQ, DM = 2048, PLE = 256;
constexpr int NQKV = 9216, NHEAD = 8, HD = 128;
constexpr int NEXP = 64, DEXP = 512, SLOTCAP = 32768;
constexpr float EPS = 1e-6f;
constexpr int NPH = 27;
constexpr int N_LAUNCHES = MK_N_LAUNCHES;
static_assert(N_LAUNCHES == 1 || N_LAUNCHES == NPH, "MK_N_LAUNCHES is 1 or 27");

constexpr size_t MiB = 1u << 20;
constexpr size_t WS_CTL = 0, CTL_ZERO_BYTES = 2 * MiB;
constexpr int CW_BAR = 1024;
constexpr int CW_CNT = 8192;
constexpr int CW_ROWSS = 65536;
constexpr size_t WS_RSX = 2 * MiB, WS_RSH3 = 2 * MiB + 256 * 1024, WS_CLAM = 2 * MiB + 512 * 1024;
constexpr size_t WS_W_IN = 4 * MiB, WS_W_G = 20 * MiB, WS_W_OUT = 22 * MiB, WS_W_QKV = 30 * MiB, WS_W_O = 66 * MiB, WS_W_R = 70 * MiB, WS_W_PP = 72 * MiB,
                 WS_W_PG = 74 * MiB, WS_W_GU = 90 * MiB, WS_W_D = 602 * MiB;
constexpr size_t WS_HB = 858 * MiB, WS_PB = 986 * MiB, WS_COS = 1018 * MiB, WS_SIN = 1026 * MiB, WS_LOGITS = 1034 * MiB, WS_SLOT_AID = 1050 * MiB,
                 WS_SLOT_GATE = 1058 * MiB, WS_SP = 1066 * MiB, WS_SH = 1068 * MiB, WS_CIN = 1070 * MiB, WS_LSE = 1072 * MiB, WS_SCR = 1076 * MiB;
constexpr size_t WS_PROJ = WS_SCR, WS_XC = WS_SCR + 256 * MiB, WS_LA = WS_SCR + 384 * MiB, WS_U = WS_SCR + 512 * MiB;
constexpr size_t WS_QKV = WS_SCR, WS_OG = WS_SCR + 576 * MiB, WS_OB = WS_SCR + 768 * MiB;
constexpr size_t WS_HID = WS_SCR, WS_YB = WS_SCR + 80 * MiB, WS_EG = WS_SCR + 336 * MiB;
constexpr size_t WS_H8 = WS_SCR + 832 * MiB;
constexpr size_t WS_END = WS_H8 + 64 * MiB;
static_assert(WS_END <= 2048 * MiB, "workspace map");

constexpr int RING_BYTES = 131072, MISC_OFF = RING_BYTES, LDS_BYTES = 147456;
constexpr int MO_BARW = 0, MO_CNT = 64, MO_MTPRE = 320, MO_T2E = 640, MO_HIST = 1280;

typedef _Float16 h16x2 __attribute__((ext_vector_type(2)));
typedef float f32x2_t __attribute__((ext_vector_type(2)));
typedef __bf16 bf16x2_t __attribute__((ext_vector_type(2)));
DI unsigned cvt_pk_bf16(float lo, float hi) { const f32x2_t v = {lo, hi}; return __builtin_bit_cast(unsigned, __builtin_convertvector(v, bf16x2_t)); }
DI unsigned pk4_fp8(float a, float b, float c, float d) { unsigned w = 0u; w = __builtin_amdgcn_cvt_pk_fp8_f32(a, b, w, false); w = __builtin_amdgcn_cvt_pk_fp8_f32(c, d, w, true); return w; }
DI void unpack8_fp8(const u32x2 w, float (&v)[8]) { const f32x2_t a = __builtin_amdgcn_cvt_pk_f32_fp8(w.x, false), b = __builtin_amdgcn_cvt_pk_f32_fp8(w.x, true), c = __builtin_amdgcn_cvt_pk_f32_fp8(w.y, false), d = __builtin_amdgcn_cvt_pk_f32_fp8(w.y, true);
    v[0] = a[0]; v[1] = a[1]; v[2] = b[0]; v[3] = b[1]; v[4] = c[0]; v[5] = c[1]; v[6] = d[0]; v[7] = d[1]; }
DI float bflo(unsigned w) { return __uint_as_float(w << 16); }
DI float bfhi(unsigned w) { return __uint_as_float(w & 0xffff0000u); }
DI u32x4 pack8(const f32x4 a, const f32x4 b) { u32x4 w; w.x = cvt_pk_bf16(a[0], a[1]); w.y = cvt_pk_bf16(a[2], a[3]); w.z = cvt_pk_bf16(b[0], b[1]); w.w = cvt_pk_bf16(b[2], b[3]); return w; }
DI void unpack8(const u32x4 w, float (&v)[8]) { v[0] = bflo(w.x); v[1] = bfhi(w.x); v[2] = bflo(w.y); v[3] = bfhi(w.y); v[4] = bflo(w.z); v[5] = bfhi(w.z); v[6] = bflo(w.w); v[7] = bfhi(w.w); }
template <int CTRL> DI float dpp_mov(float v) { return __builtin_bit_cast(float, __builtin_amdgcn_update_dpp(0, __builtin_bit_cast(int, v), CTRL, 0xf, 0xf, false)); }
DI float row16_sum(float v) {
    v += dpp_mov<0xB1>(v);
    v += dpp_mov<0x4E>(v);
    v += dpp_mov<0x141>(v);
    v += dpp_mov<0x140>(v);
    return v;
}
DI float row16_xor8(float v) { return dpp_mov<0x128>(v); }
DI float wave_sum(float v) {
#pragma unroll
    for (int o = 1; o < 64; o <<= 1) v += __shfl_xor(v, o);
    return v;
}
typedef unsigned long long rs_t;
constexpr float RS_SCALE = 1048576.0f, RS_INV = 1.0f / (1048576.0f * 2048.0f);
DI rs_t rs_fix(float ss) { return (rs_t)(ss * RS_SCALE + 0.5f); }
DI float rs_rstd(rs_t v) { return __builtin_amdgcn_rsqf((float)v * RS_INV + 1e-6f); }
DI float sigmoidf_(float x) { return __builtin_amdgcn_rcpf(1.0f + __expf(-x)); }
typedef __attribute__((address_space(4))) const unsigned long long ka_u64;
#define GAS __attribute__((address_space(1)))
DI const void* karg_ptr(int i) { ka_u64* kb = (ka_u64*)__builtin_amdgcn_kernarg_segment_ptr(); asm volatile("" : "+s"(kb)); return (const void*)(const GAS void*)kb[i]; }
#define KF(i) ((const float*)karg_ptr(i))
enum { A_X = 0, A_P, A_POS, A_NORM_MIX, A_NORM_FFN, A_W_IN, A_CONV_W, A_CONV_B, A_W_RG, A_B_RG, A_W_IG, A_B_IG, A_LAM, A_W_OUT, A_W_QKV, A_Q_GAIN, A_K_GAIN, A_W_O,
       A_W_GROUP, A_B_GROUP, A_W_EXPERT, A_B_EXPERT, A_W_GATE, A_W_UP, A_W_DOWN, A_PLE_PROJ, A_PLE_GATE, A_PLE_NORM, A_OUT, A_WS };
#define LDS_WAIT() asm volatile("s_waitcnt lgkmcnt(0)" ::: "memory")
#define VM_WAIT() asm volatile("s_waitcnt vmcnt(0)" ::: "memory")

#define XB_TMO      128
#define XB_XCNT(j)  (256  + 64 * (j))
#define XB_XSUB(j)  (1280 + 64 * (j))
#define XB_XGEN(j)  (2304 + 64 * (j))
#define XB_TOP      3328
#define XB_TOPGEN   3392
#define XCD_BAR_WORDS 3456
#define XB_SPIN_CAP (1u << 21)

__device__ __forceinline__ unsigned xb_ld(unsigned* p)              { return __hip_atomic_load(p, __ATOMIC_RELAXED, __HIP_MEMORY_SCOPE_AGENT); }
__device__ __forceinline__ unsigned xb_add(unsigned* p, unsigned v) { return __hip_atomic_fetch_add(p, v, __ATOMIC_RELAXED, __HIP_MEMORY_SCOPE_AGENT); }
__device__ __forceinline__ unsigned xb_xcc_id() { return (unsigned)__builtin_amdgcn_s_getreg((3 << 11) | 20) & 0xFu; }
#define XB_SPIN(cond, bar) do { unsigned _sp = 0; while (cond) { __builtin_amdgcn_s_sleep(1); \
    if ((++_sp & 255u) == 0u) { if (xb_ld(&(bar)[XB_TMO])) break; if (_sp > XB_SPIN_CAP) { atomicAdd(&(bar)[XB_TMO], 1u); break; } } } } while (0)

struct XcdBarrier {
    unsigned* bar; unsigned x;
    volatile LAS unsigned* st;
};
__device__ __forceinline__ XcdBarrier xcd_barrier_post(unsigned* bar, volatile LAS unsigned* st, const int tid) {
    XcdBarrier b; b.bar = bar; b.x = xb_xcc_id(); b.st = st;
    if (tid == 0) (void)xb_add(&bar[XB_XCNT(b.x)], 1u);
    return b;
}
__device__ __forceinline__ void xcd_barrier_complete(unsigned* bar, unsigned x, unsigned& nloc, unsigned& nx) {
    const unsigned G = gridDim.x * gridDim.y * gridDim.z;
    unsigned sum, cnt, mine, sp = 0u;
    for (;;) {
        sum = 0u; cnt = 0u; mine = 0u;
#pragma unroll
        for (unsigned j = 0; j < 16; ++j) { const unsigned c = xb_ld(&bar[XB_XCNT(j)]); sum += c; cnt += (c > 0u) ? 1u : 0u; mine = (j == x) ? c : mine; }
        if (sum == G) break;
        __builtin_amdgcn_s_sleep(1);
        if ((++sp & 255u) == 0u) { if (xb_ld(&bar[XB_TMO])) break; if (sp > XB_SPIN_CAP) { atomicAdd(&bar[XB_TMO], 1u); break; } }
    }
    nloc = mine > 0u ? mine : 1u; nx = cnt > 0u ? cnt : 1u;
}
__device__ __forceinline__ void xcd_barrier(const XcdBarrier& b, const int tid) {
    asm volatile("s_waitcnt vmcnt(0)" ::: "memory");
    __syncthreads();
    if (tid == 0) {
        unsigned* bar = b.bar;
        __builtin_amdgcn_s_waitcnt(0);
        unsigned nloc = b.st[0], nx = b.st[1];
        if (nloc == 0u) { xcd_barrier_complete(bar, b.x, nloc, nx); b.st[0] = nloc; b.st[1] = nx; }
        const unsigned old = xb_add(&bar[XB_XSUB(b.x)], 1u);
        const unsigned gen = old / nloc;
        if (old + 1u == (gen + 1u) * nloc) {
            __builtin_amdgcn_fence(__ATOMIC_RELEASE, "agent");
            asm volatile("s_waitcnt vmcnt(0)" ::: "memory");
            const unsigned og = xb_add(&bar[XB_TOP], 1u);
            const unsigned tg = og / nx;
            if (og + 1u == (tg + 1u) * nx) xb_add(&bar[XB_TOPGEN], 1u);
            else XB_SPIN(xb_ld(&bar[XB_TOPGEN]) == tg, bar);
            __builtin_amdgcn_fence(__ATOMIC_ACQUIRE, "agent");
            xb_add(&bar[XB_XGEN(b.x)], 1u);
            asm volatile("s_waitcnt vmcnt(0)" ::: "memory");
        } else {
            XB_SPIN(xb_ld(&bar[XB_XGEN(b.x)]) == gen, bar);
            __builtin_amdgcn_fence(__ATOMIC_ACQUIRE, "agent");
            asm volatile("s_waitcnt vmcnt(0)" ::: "memory");
        }
    }
    __syncthreads();
}

namespace g8 {
constexpr int BM = 256, BK = 64, HALF = 128, HTB = HALF * BK * 2, NXCD = 8, WGM = 8;
DI int lds_byte(int r, int c) { const int st = (r >> 4) * 2 + (c >> 5), rr = r & 15, cc = c & 31, ob = rr * 64 + cc * 2; return st * 1024 + (ob ^ (((ob >> 9) & 1) << 5)); }
DI void stage_rc(int b, int& R, int& C) { const int st = b / 1024, sb = b % 1024, swz = sb ^ (((sb >> 9) & 1) << 5); R = (st >> 1) * 16 + swz / 64; C = (st & 1) * 32 + (swz % 64) / 2; }
DI int s8(int fr) { return ((fr >> 1) & 1) | (((-(fr >> 2)) & 3) << 1); }
DI int lds_byte8(int r, int cbyte) { return r * 128 + ((((cbyte >> 4) ^ s8(r & 15)) << 4) | (cbyte & 15)); }
DI void stage_rc8(int b, int& R, int& Cbyte) { R = b >> 7; Cbyte = (((b >> 4) & 7) ^ s8(R & 15)) << 4; }
DI int perm32(int rho) { const int n = rho >> 4, i = rho & 15; return 8 * (i >> 2) + 4 * n + (i & 3); }

struct Unit { const char* a; const char* b; int r0, c0, x0, x1, x2; };

DI int xcd_remap(int L, int nwg) { const int q = nwg / NXCD, r = nwg % NXCD, xcd = L % NXCD, off = L / NXCD; return (xcd < r ? xcd * (q + 1) : r * (q + 1) + (xcd - r) * q) + off; }

struct StaticSched {
    static constexpr bool GATHER = false;
    const char* A; const char* B; unsigned lda, ldb; int nM, nN, nwg, G, c, upv, nv;
    DI void init(const void* A_, unsigned lda_, const void* B_, unsigned ldb_, int nM_, int nN_, int G_, int c_) { A = (const char*)A_; B = (const char*)B_; lda = lda_; ldb = ldb_; nM = nM_; nN = nN_; nwg = nM * nN; G = G_; c = c_; upv = 1 << 30; nv = 1; }
    DI void deal(int vG, int v0, int nv_) { G = vG; c = v0; nv = nv_; upv = (nwg + vG - 1) / vG; }
    DI bool next(int i, Unit& u) const {
        const int vi = i / upv, j = i - vi * upv; if (vi >= nv) return false;
        const int L = j * G + c + vi; if (L >= nwg) return false;
        const int wgid = xcd_remap(L, nwg);
        const int nig = WGM * nN, gid = wgid / nig, fm = gid * WGM, gsz = (nM - fm) < WGM ? (nM - fm) : WGM;
        const int pm = fm + ((wgid % nig) % gsz), pn = (wgid % nig) / gsz;
        u.a = A + (size_t)pm * 256 * lda; u.b = B + (size_t)pn * 256 * ldb; u.r0 = pm * 256; u.c0 = pn * 256; u.x0 = 0; u.x1 = 0; u.x2 = 0; return true;
    }
    DI unsigned gather(const Unit&, int) const { return 0u; }
};
struct GateSched {
    static constexpr bool GATHER = false;
    const char* A; const char* B; int nwg, G, c;
    DI void init(const void* A_, const void* B_, int G_, int c_) { A = (const char*)A_; B = (const char*)B_; nwg = (T / 256) * 16; G = G_; c = c_; }
    DI bool next(int i, Unit& u) const {
        const int L = i * G + c; if (L >= nwg) return false;
        const int wgid = xcd_remap(L, nwg);
        const int nN = 16, nM = T / 256, nig = WGM * nN, gid = wgid / nig, fm = gid * WGM, gsz = (nM - fm) < WGM ? (nM - fm) : WGM;
        const int pm = fm + ((wgid % nig) % gsz), pn = (wgid % nig) / gsz, blk = pn >> 1, j = pn & 1;
        u.a = A + (size_t)pm * 256 * (DM * 2) + blk * 512; u.b = B + (size_t)pn * 256 * 512; u.r0 = pm * 256; u.c0 = blk * 256 + j * 128; u.x0 = 0; u.x1 = 0; u.x2 = 0; return true;
    }
    DI unsigned gather(const Unit&, int) const { return 0u; }
};
template <int NJ, bool GATH> struct MoeSched {
    static constexpr bool GATHER = GATH;
    const char* A; const char* B; unsigned lda, ldbt  ; size_t bexp  ; const int* slot_aid; LAS unsigned char* misc; int nwg, G, c;
    DI void init(const void* A_, unsigned lda_, const void* B_, unsigned ldb_, size_t bexp_, const int* slot_aid_, LAS unsigned char* misc_, int G_, int c_) {
        A = (const char*)A_; lda = lda_; B = (const char*)B_; ldbt = 256u * ldb_; bexp = bexp_; slot_aid = slot_aid_; misc = misc_; G = G_; c = c_;
        nwg = ((const LAS int*)(misc + MO_MTPRE))[64] * NJ; }
    DI bool next(int i, Unit& u) const {
        const int L = i * G + c; if (L >= nwg) return false;
        const int idx = xcd_remap(L, nwg), mt = idx / NJ, j = idx % NJ;
        const int e = __builtin_amdgcn_readfirstlane((int)((const LAS unsigned char*)(misc + MO_T2E))[mt]);
        const int pre = __builtin_amdgcn_readfirstlane(((const LAS int*)(misc + MO_MTPRE))[e]);
        const int cn = __builtin_amdgcn_readfirstlane(((const LAS int*)(misc + MO_CNT))[e]);
        const int pos0 = (mt - pre) * 256;
        u.a = GATH ? A : A + (size_t)mt * 256 * lda; u.b = B + (size_t)e * bexp + (size_t)j * ldbt;
        u.r0 = mt * 256; u.c0 = j; u.x0 = e * SLOTCAP + pos0; u.x1 = pos0; u.x2 = cn - pos0; return true;
    }
    DI unsigned gather(const Unit& u, int row) const { const int rc = row < u.x2 ? row : u.x2 - 1; const int aid = slot_aid[u.x0 + rc]; return (unsigned)(aid >> 1) * lda; }
};

template <class Epi, class Sched>
DI void gemm_phase(LAS unsigned char* lds, const int tid, const int K, const unsigned lda, const unsigned ldb, const Sched& S, const Epi& E) {
    const int wid = __builtin_amdgcn_readfirstlane(tid >> 6), lane = tid & 63, wr = wid >> 2, wc = wid & 3, fr = lane & 15, fq = lane >> 4;
    const int nt = K / BK;
    unsigned voffA[2], voffB[2]; int rowA[2]; unsigned colA[2];
#pragma unroll
    for (int i = 0; i < 2; ++i) { int R, C2; if constexpr (Epi::FP8) stage_rc8(tid * 16 + i * 8192, R, C2); else { int C; stage_rc(tid * 16 + i * 8192, R, C); C2 = C * 2; }
        const int Rb = Epi::PERM ? ((R & ~31) + perm32(R & 31)) : R;
        voffA[i] = (unsigned)R * lda + (unsigned)C2; voffB[i] = (unsigned)Rb * ldb + (unsigned)C2; rowA[i] = R; colA[i] = (unsigned)C2; }
    const size_t kstep = (size_t)(BK * 2);
    const size_t hA = (size_t)HALF * lda, hB = (size_t)HALF * ldb;
    const unsigned ldsw = (unsigned)wid * 1024u;
    constexpr bool FP8 = Epi::FP8; constexpr bool HALFN = Epi::HALFN;
    const int aoff = FP8 ? lds_byte8(wr * 64 + fr, 32 * fq) : lds_byte(wr * 64 + fr, fq * 8), boff = FP8 ? lds_byte8(wc * 32 + fr, 32 * fq) : lds_byte(wc * 32 + fr, fq * 8);
    const int aoff1 = aoff ^ 16, boff1 = boff ^ 16;
    unsigned gc[2][2] = {{0u, 0u}, {0u, 0u}}, gn[2][2] = {{0u, 0u}, {0u, 0u}};
#define G8_SA(b, h) (((b) * 2 + (h)) * HTB)
#define G8_SB(b, h) ((4 + (b) * 2 + (h)) * HTB)
#define G8_GLDS(gp, ldsoff) __builtin_amdgcn_global_load_lds((const unsigned*)(gp), (LAS unsigned*)(lds + (ldsoff)), 16, 0, 0)
#define G8_STAGE_B(bufoff, gbase) do { G8_GLDS((gbase) + voffB[0], (bufoff) + ldsw); G8_GLDS((gbase) + voffB[1], (bufoff) + ldsw + 8192); } while (0)
#define G8_STAGE_A(bufoff, kptr, h, nx) do { if constexpr (Sched::GATHER) { \
        const unsigned o0_ = (nx) ? gn[h][0] : gc[h][0], o1_ = (nx) ? gn[h][1] : gc[h][1]; \
        G8_GLDS((kptr) + o0_, (bufoff) + ldsw); G8_GLDS((kptr) + o1_, (bufoff) + ldsw + 8192); } \
    else { G8_GLDS((kptr) + (h) * hA + voffA[0], (bufoff) + ldsw); G8_GLDS((kptr) + (h) * hA + voffA[1], (bufoff) + ldsw + 8192); } } while (0)
#define G8_LDA(b, h) do { if constexpr (FP8) { _Pragma("unroll") for (int m = 0; m < 4; ++m) { const bf16x8 lo_ = *(const LAS bf16x8*)(lds + G8_SA(b, h) + aoff + m * 2048), hi_ = *(const LAS bf16x8*)(lds + G8_SA(b, h) + aoff1 + m * 2048); A8[m] = __builtin_bit_cast(i32x8, __builtin_shufflevector(lo_, hi_, 0, 1, 2, 3, 4, 5, 6, 7, 8, 9, 10, 11, 12, 13, 14, 15)); } } \
    else { _Pragma("unroll") for (int m = 0; m < 4; ++m) _Pragma("unroll") for (int k = 0; k < 2; ++k) At[m][k] = *(const LAS bf16x8*)(lds + G8_SA(b, h) + aoff + m * 2048 + k * 1024); } } while (0)
#define G8_LDB(w, b, h) do { if constexpr (FP8) { _Pragma("unroll") for (int n = 0; n < 2; ++n) { const bf16x8 lo_ = *(const LAS bf16x8*)(lds + G8_SB(b, h) + boff + n * 2048), hi_ = *(const LAS bf16x8*)(lds + G8_SB(b, h) + boff1 + n * 2048); B8[w][n] = __builtin_bit_cast(i32x8, __builtin_shufflevector(lo_, hi_, 0, 1, 2, 3, 4, 5, 6, 7, 8, 9, 10, 11, 12, 13, 14, 15)); } } \
    else { _Pragma("unroll") for (int n = 0; n < 2; ++n) _Pragma("unroll") for (int k = 0; k < 2; ++k) Bq[w][n][k] = *(const LAS bf16x8*)(lds + G8_SB(b, h) + boff + n * 2048 + k * 1024); } } while (0)
#define G8_MMA(ai, bj, w) do { __builtin_amdgcn_s_setprio(1); if constexpr (FP8) { _Pragma("unroll") for (int m = 0; m < 4; ++m) _Pragma("unroll") for (int n = 0; n < 2; ++n) \
        asm volatile("v_mfma_scale_f32_16x16x128_f8f6f4 %0, %1, %2, %0, %3, %3 op_sel_hi:[0,0,0]" : "+v"(acc[ai][bj][m][n]) : "v"(B8[w][n]), "v"(A8[m]), "v"(one_scale)); } \
    else { _Pragma("unroll") for (int m = 0; m < 4; ++m) _Pragma("unroll") for (int n = 0; n < 2; ++n) _Pragma("unroll") for (int k = 0; k < 2; ++k) \
        acc[ai][bj][m][n] = __builtin_amdgcn_mfma_f32_16x16x32_bf16(Bq[w][n][k], At[m][k], acc[ai][bj][m][n], 0, 0, 0); } __builtin_amdgcn_s_setprio(0); } while (0)
#define G8_WAIT_V(n) asm volatile("s_waitcnt vmcnt(" #n ")" ::: "memory")
#define G8_WAIT_L(n) asm volatile("s_waitcnt lgkmcnt(" #n ")" ::: "memory")
#define G8_BAR __builtin_amdgcn_s_barrier()
#define G8_SCHED __builtin_amdgcn_sched_barrier(0)
#define G8_GOFF(dst, u) do { if constexpr (Sched::GATHER) { _Pragma("unroll") for (int h_ = 0; h_ < 2; ++h_) _Pragma("unroll") for (int i_ = 0; i_ < 2; ++i_) dst[h_][i_] = S.gather(u, h_ * 128 + rowA[i_]) + colA[i_]; } } while (0)
    Unit cur, nxt; int ui = 0;
    if (!S.next(0, cur)) return;
    f32x4 acc[2][2][4][2];
#pragma unroll
    for (int a = 0; a < 2; ++a)
#pragma unroll
        for (int b = 0; b < 2; ++b)
#pragma unroll
            for (int m = 0; m < 4; ++m)
#pragma unroll
                for (int n = 0; n < 2; ++n) acc[a][b][m][n] = (f32x4){0.f, 0.f, 0.f, 0.f};
    bf16x8 At[4][2], Bq[2][2][2]; i32x8 A8[4], B8[2][2];
    const int one_scale = 0x7f7f7f7f;
    const char* cA = cur.a; const char* cB = cur.b;
    G8_GOFF(gc, cur);
    G8_STAGE_B(G8_SB(0, 0), cB); G8_STAGE_B(G8_SB(0, 1), cB + hB); G8_STAGE_A(G8_SA(0, 0), cA, 0, false); G8_STAGE_A(G8_SA(0, 1), cA, 1, false);
    if (wr == 1) G8_BAR;
    G8_WAIT_V(2); G8_BAR;
    G8_STAGE_B(G8_SB(1, 0), cB + kstep); G8_STAGE_A(G8_SA(1, 0), cA + kstep, 0, false); G8_STAGE_B(G8_SB(1, 1), cB + hB + kstep);
    G8_WAIT_V(6); G8_BAR;
    for (;;) {
        const bool has_next = S.next(ui + 1, nxt);
        const char* nA = has_next ? nxt.a : cA; const char* nB = has_next ? nxt.b : cB;
        if constexpr (Sched::GATHER) { if (has_next) { G8_GOFF(gn, nxt); } else {
#pragma unroll
            for (int h_ = 0; h_ < 2; ++h_)
#pragma unroll
                for (int i_ = 0; i_ < 2; ++i_) gn[h_][i_] = gc[h_][i_]; } }
        for (int t = 0; t < nt; t += 2) {
            const bool last = (t == nt - 2);
            const char* a1 = cA + (size_t)(t + 1) * kstep;
            const char* a2 = last ? nA : cA + (size_t)(t + 2) * kstep; const char* b2 = last ? nB : cB + (size_t)(t + 2) * kstep;
            const char* a3 = a2 + kstep; const char* b3 = b2 + kstep;
            G8_LDB(0, 0, 0); if constexpr (!HALFN) G8_LDB(1, 0, 1); G8_SCHED; G8_LDA(0, 0); G8_STAGE_A(G8_SA(1, 1), a1, 1, false);
            G8_WAIT_V(8); G8_WAIT_L(0); G8_BAR; G8_MMA(0, 0, 0); if constexpr (!HALFN) G8_MMA(0, 1, 1); G8_BAR; G8_SCHED;
            G8_LDA(0, 1); G8_STAGE_B(G8_SB(0, 0), b2); G8_STAGE_B(G8_SB(0, 1), b2 + hB); G8_STAGE_A(G8_SA(0, 0), a2, 0, last);
            G8_WAIT_V(8); G8_WAIT_L(0); G8_BAR; G8_MMA(1, 0, 0); if constexpr (!HALFN) G8_MMA(1, 1, 1); G8_BAR; G8_SCHED;
            G8_LDB(0, 1, 0); if constexpr (!HALFN) G8_LDB(1, 1, 1); G8_SCHED; G8_LDA(1, 0); G8_STAGE_A(G8_SA(0, 1), a2, 1, last);
            G8_WAIT_V(8); G8_WAIT_L(0); G8_BAR; G8_MMA(0, 0, 0); if constexpr (!HALFN) G8_MMA(0, 1, 1); G8_BAR; G8_SCHED;
            G8_LDA(1, 1); G8_STAGE_B(G8_SB(1, 0), b3); G8_STAGE_B(G8_SB(1, 1), b3 + hB); G8_STAGE_A(G8_SA(1, 0), a3, 0, last);
            G8_WAIT_V(8); G8_WAIT_L(0); G8_BAR; G8_MMA(1, 0, 0); if constexpr (!HALFN) G8_MMA(1, 1, 1); G8_BAR; G8_SCHED;
        }
        if (wr == 0) G8_BAR;
        if constexpr (FP8) asm volatile("s_nop 15\n\ts_nop 15" ::: "memory");
        { int l2 = (int)__builtin_amdgcn_mbcnt_hi(~0u, __builtin_amdgcn_mbcnt_lo(~0u, 0u)); asm volatile("" : "+v"(l2));
          E(acc, cur, wr, wc, l2 & 15, l2 >> 4); }
        if (!has_next) break;
#pragma unroll
        for (int a = 0; a < 2; ++a)
#pragma unroll
            for (int b = 0; b < 2; ++b)
#pragma unroll
                for (int m = 0; m < 4; ++m)
#pragma unroll
                    for (int n = 0; n < 2; ++n) acc[a][b][m][n] = (f32x4){0.f, 0.f, 0.f, 0.f};
        cur = nxt; cA = nA; cB = nB; ++ui;
        if constexpr (Sched::GATHER) {
#pragma unroll
            for (int h_ = 0; h_ < 2; ++h_)
#pragma unroll
                for (int i_ = 0; i_ < 2; ++i_) gc[h_][i_] = gn[h_][i_]; }
        if (wr == 1) G8_BAR;
    }
    G8_WAIT_V(0);
    G8_BAR;
#undef G8_SA
#undef G8_SB
#undef G8_GLDS
#undef G8_STAGE_A
#undef G8_STAGE_B
#undef G8_LDA
#undef G8_LDB
#undef G8_MMA
#undef G8_WAIT_V
#undef G8_WAIT_L
#undef G8_BAR
#undef G8_SCHED
#undef G8_GOFF
}

#define EPI_ROWS(ai, m) ((ai) * 128 + wr * 64 + (m) * 16 + fr)

template <bool F8> struct EpiBf16ScaleT {
    static constexpr bool PERM = true; static constexpr bool FP8 = F8; static constexpr bool HALFN = false;
    bf16_t* O; int ldc; const rs_t* rowss; float mul;
    DI void operator()(const f32x4 (&acc)[2][2][4][2], const Unit& u, int wr, int wc, int fr, int fq) const {
        rs_t rs[2][4];
#pragma unroll
        for (int ai = 0; ai < 2; ++ai)
#pragma unroll
            for (int m = 0; m < 4; ++m) rs[ai][m] = rowss ? rowss[u.r0 + EPI_ROWS(ai, m)] : 0ull;
#pragma unroll
        for (int ai = 0; ai < 2; ++ai)
#pragma unroll
            for (int m = 0; m < 4; ++m) {
                const int row = u.r0 + EPI_ROWS(ai, m);
                const float sc = (rowss ? rs_rstd(rs[ai][m]) : 1.0f) * mul;
                bf16_t* rowp = O + (size_t)row * ldc + u.c0 + wc * 32 + 8 * fq;
#pragma unroll
                for (int bj = 0; bj < 2; ++bj) *(u32x4*)(rowp + bj * 128) = pack8(acc[ai][bj][m][0] * sc, acc[ai][bj][m][1] * sc);
            }
    }
};
typedef EpiBf16ScaleT<false> EpiBf16Scale;
DI int qkv_plane_row(int t, int dsh) { const int b = t >> 14, sp = t & (SEQ - 1); return (b << 14) + (sp & ((1 << dsh) - 1)) * (SEQ >> dsh) + (sp >> dsh); }
struct EpiQkvPlanes {
    static constexpr bool PERM = true; static constexpr bool FP8 = true; static constexpr bool HALFN = false;
    unsigned char* O; const rs_t* rowss; float mul;
    DI void operator()(const f32x4 (&acc)[2][2][4][2], const Unit& u, int wr, int wc, int fr, int fq) const {
        const int pn = u.c0 >> 8, g = pn / 12, dsh = 2 * g;
        const size_t plane0 = (size_t)(pn >> 2) * 8 + (pn & 3) * 2;
        rs_t rs[2][4];
#pragma unroll
        for (int ai = 0; ai < 2; ++ai)
#pragma unroll
            for (int m = 0; m < 4; ++m) rs[ai][m] = rowss[u.r0 + EPI_ROWS(ai, m)];
#pragma unroll
        for (int ai = 0; ai < 2; ++ai)
#pragma unroll
            for (int m = 0; m < 4; ++m) {
                const int prow = qkv_plane_row(u.r0 + EPI_ROWS(ai, m), dsh);
                const float sc = rs_rstd(rs[ai][m]) * mul;
                unsigned char* rowp = O + (plane0 * T + prow) * HD + wc * 32 + 8 * fq;
#pragma unroll
                for (int bj = 0; bj < 2; ++bj) { const f32x4 a0 = acc[ai][bj][m][0] * sc, a1 = acc[ai][bj][m][1] * sc; u32x2 q; q.x = pk4_fp8(a0[0], a0[1], a0[2], a0[3]); q.y = pk4_fp8(a1[0], a1[1], a1[2], a1[3]); *(u32x2*)(rowp + (size_t)bj * T * HD) = q; }
            }
    }
};
struct EpiGates {
    static constexpr bool PERM = true; static constexpr bool FP8 = false; static constexpr bool HALFN = false;
    const bf16_t* XC; const float* b_rg; const float* b_ig; const float* clam; bf16_t* LA; bf16_t* U;
    DI void operator()(const f32x4 (&acc)[2][2][4][2], const Unit& u, int wr, int wc, int fr, int fq) const {
        const int ch = u.c0 + wc * 32 + 8 * fq;
        float br[8], bi[8], cl[8];
        { const f32x4 a = *(const f32x4*)(b_rg + ch), b = *(const f32x4*)(b_rg + ch + 4), c = *(const f32x4*)(b_ig + ch), d = *(const f32x4*)(b_ig + ch + 4), e = *(const f32x4*)(clam + ch), f = *(const f32x4*)(clam + ch + 4);
#pragma unroll
          for (int j = 0; j < 4; ++j) { br[j] = a[j]; br[4 + j] = b[j]; bi[j] = c[j]; bi[4 + j] = d[j]; cl[j] = e[j]; cl[4 + j] = f[j]; } }
        const unsigned off0 = ((unsigned)(u.r0 + wr * 64 + fr) * DM + (unsigned)ch) * 2u;
#pragma unroll
        for (int ai = 0; ai < 2; ++ai)
#pragma unroll
            for (int m = 0; m < 4; ++m) {
                const unsigned off = off0 + (unsigned)((ai * 128 + m * 16) * DM * 2);
                float xv[8]; unpack8(*(const u32x4*)((const char*)XC + off), xv);
                float la[8], uu[8];
#pragma unroll
                for (int j = 0; j < 8; ++j) {
                    const float r = sigmoidf_(acc[ai][0][m][j >> 2][j & 3] + br[j]), ig = sigmoidf_(acc[ai][1][m][j >> 2][j & 3] + bi[j]);
                    const float l = r * cl[j];
                    la[j] = l;
                    const float om = 1.0f - __expf(2.0f * l);
                    uu[j] = __builtin_amdgcn_sqrtf(om > 0.f ? om : 0.f) * (ig * xv[j]);
                }
                u32x4 lw = pack8((f32x4){la[0], la[1], la[2], la[3]}, (f32x4){la[4], la[5], la[6], la[7]});
                u32x4 uw = pack8((f32x4){uu[0], uu[1], uu[2], uu[3]}, (f32x4){uu[4], uu[5], uu[6], uu[7]});
                asm volatile("" : "+v"(lw), "+v"(uw));
                *(u32x4*)((char*)LA + off) = lw; *(u32x4*)((char*)U + off) = uw;
                asm volatile("" ::: "memory");
            }
    }
};
template <bool F8> struct EpiResidT {
    static constexpr bool PERM = true; static constexpr bool FP8 = F8; static constexpr bool HALFN = false;
    bf16_t* hb; unsigned char* h8; rs_t* rowss; float mul;
    DI void operator()(const f32x4 (&acc)[2][2][4][2], const Unit& u, int wr, int wc, int fr, int fq) const {
        const unsigned off0 = ((unsigned)(u.r0 + wr * 64 + fr) * DM + (unsigned)(u.c0 + wc * 32 + 8 * fq)) * 2u;
#pragma unroll
        for (int ai = 0; ai < 2; ++ai)
#pragma unroll
            for (int m = 0; m < 4; ++m) {
                const int row = u.r0 + EPI_ROWS(ai, m);
                const unsigned off = off0 + (unsigned)((ai * 128 + m * 16) * DM * 2);
                float ss = 0.f;
#pragma unroll
                for (int bj = 0; bj < 2; ++bj) {
                    float rv[8]; unpack8(*(const u32x4*)((const char*)hb + off + bj * 256), rv);
                    const f32x4 h0 = (f32x4){rv[0], rv[1], rv[2], rv[3]} + acc[ai][bj][m][0] * mul, h1 = (f32x4){rv[4], rv[5], rv[6], rv[7]} + acc[ai][bj][m][1] * mul;
                    *(u32x4*)((char*)hb + off + bj * 256) = pack8(h0, h1);
                    { u32x2 q; q.x = pk4_fp8(h0[0], h0[1], h0[2], h0[3]); q.y = pk4_fp8(h1[0], h1[1], h1[2], h1[3]); *(u32x2*)(h8 + (off >> 1) + bj * 128) = q; }
                    ss += (h0[0] * h0[0] + h0[1] * h0[1]) + (h0[2] * h0[2] + h0[3] * h0[3]) + (h1[0] * h1[0] + h1[1] * h1[1]) + (h1[2] * h1[2] + h1[3] * h1[3]);
                }
                ss += __shfl_xor(ss, 16); ss += __shfl_xor(ss, 32);
                if (fq == 0) atomicAdd(rowss + row, rs_fix(ss));
            }
    }
};
struct EpiLogits {
    static constexpr bool PERM = false; static constexpr bool FP8 = false; static constexpr bool HALFN = true;
    float* L; const rs_t* rowss;
    DI void operator()(const f32x4 (&acc)[2][2][4][2], const Unit& u, int wr, int wc, int fr, int fq) const {
        rs_t rs[2][4];
#pragma unroll
        for (int ai = 0; ai < 2; ++ai)
#pragma unroll
            for (int m = 0; m < 4; ++m) rs[ai][m] = rowss[u.r0 + EPI_ROWS(ai, m)];
#pragma unroll
        for (int ai = 0; ai < 2; ++ai)
#pragma unroll
            for (int m = 0; m < 4; ++m) {
                const int row = u.r0 + EPI_ROWS(ai, m);
                const float sc = rs_rstd(rs[ai][m]);
                float* rowp = L + (size_t)row * 128 + wc * 32 + 4 * fq;
#pragma unroll
                for (int n = 0; n < 2; ++n) *(f32x4*)(rowp + n * 16) = acc[ai][0][m][n] * sc;
            }
    }
};
struct EpiGU {
    static constexpr bool PERM = true; static constexpr bool FP8 = true; static constexpr bool HALFN = false;
    unsigned char* HID; const int* slot_aid; const rs_t* rowss;
    DI void operator()(const f32x4 (&acc)[2][2][4][2], const Unit& u, int wr, int wc, int fr, int fq) const {
        int aid[2][4]; rs_t rs[2][4];
#pragma unroll
        for (int ai = 0; ai < 2; ++ai)
#pragma unroll
            for (int m = 0; m < 4; ++m) { const int rt = EPI_ROWS(ai, m); aid[ai][m] = slot_aid[u.x0 + (rt < u.x2 ? rt : u.x2 - 1)]; }
#pragma unroll
        for (int ai = 0; ai < 2; ++ai)
#pragma unroll
            for (int m = 0; m < 4; ++m) rs[ai][m] = rowss[aid[ai][m] >> 1];
#pragma unroll
        for (int ai = 0; ai < 2; ++ai)
#pragma unroll
            for (int m = 0; m < 4; ++m) {
                const int rt = EPI_ROWS(ai, m);
                const float sc = rs_rstd(rs[ai][m]) * (1.0f / 64.0f);
                f32x4 h[2];
#pragma unroll
                for (int n = 0; n < 2; ++n)
#pragma unroll
                    for (int j = 0; j < 4; ++j) { const float g = acc[ai][0][m][n][j] * sc, v = acc[ai][1][m][n][j] * sc; h[n][j] = g * sigmoidf_(g) * v; }
                u32x2 q; q.x = pk4_fp8(h[0][0], h[0][1], h[0][2], h[0][3]); q.y = pk4_fp8(h[1][0], h[1][1], h[1][2], h[1][3]);
                *(u32x2*)(HID + (size_t)(u.r0 + rt) * DEXP + u.c0 * 128 + wc * 32 + 8 * fq) = q;
            }
    }
};
struct EpiDown {
    static constexpr bool PERM = true; static constexpr bool FP8 = true; static constexpr bool HALFN = false;
    unsigned char* YB; const int* slot_aid; const float* slot_gate;
    DI void operator()(const f32x4 (&acc)[2][2][4][2], const Unit& u, int wr, int wc, int fr, int fq) const {
        int aid[2][4]; float gt[2][4];
#pragma unroll
        for (int ai = 0; ai < 2; ++ai)
#pragma unroll
            for (int m = 0; m < 4; ++m) { const int rt = EPI_ROWS(ai, m), rc = rt < u.x2 ? rt : u.x2 - 1; aid[ai][m] = slot_aid[u.x0 + rc]; gt[ai][m] = slot_gate[u.x0 + rc] * (16.0f / 64.0f); }
#pragma unroll
        for (int ai = 0; ai < 2; ++ai)
#pragma unroll
            for (int m = 0; m < 4; ++m) {
                const int rt = EPI_ROWS(ai, m);
                if (rt < u.x2) {
                    unsigned char* rowp = YB + (size_t)aid[ai][m] * DM + u.c0 * 256 + wc * 32 + 8 * fq;
#pragma unroll
                    for (int bj = 0; bj < 2; ++bj) { const f32x4 a0 = acc[ai][bj][m][0] * gt[ai][m], a1 = acc[ai][bj][m][1] * gt[ai][m]; u32x2 q; q.x = pk4_fp8(a0[0], a0[1], a0[2], a0[3]); q.y = pk4_fp8(a1[0], a1[1], a1[2], a1[3]); *(u32x2*)(rowp + bj * 128) = q; }
                }
            }
    }
};
template <bool F8> struct EpiPleGT {
    static constexpr bool PERM = true; static constexpr bool FP8 = F8; static constexpr bool HALFN = false;
    bf16_t* EG; rs_t* rowss; float mul;
    DI void operator()(const f32x4 (&acc)[2][2][4][2], const Unit& u, int wr, int wc, int fr, int fq) const {
#pragma unroll
        for (int ai = 0; ai < 2; ++ai)
#pragma unroll
            for (int m = 0; m < 4; ++m) {
                const int row = u.r0 + EPI_ROWS(ai, m);
                bf16_t* rowp = EG + (size_t)row * DM + u.c0 + wc * 32 + 8 * fq;
                float ss = 0.f;
#pragma unroll
                for (int bj = 0; bj < 2; ++bj) {
                    float ev[8]; unpack8(*(const u32x4*)(rowp + bj * 128), ev);
                    f32x4 o[2];
#pragma unroll
                    for (int j = 0; j < 8; ++j) { const float v = ev[j] * sigmoidf_(acc[ai][bj][m][j >> 2][j & 3] * mul); o[j >> 2][j & 3] = v; ss += v * v; }
                    *(u32x4*)(rowp + bj * 128) = pack8(o[0], o[1]);
                }
                ss += __shfl_xor(ss, 16); ss += __shfl_xor(ss, 32);
                if (fq == 0) atomicAdd(rowss + row, rs_fix(ss));
            }
    }
};
}

struct Ctx { LAS unsigned char* lds; int tid, lane, wave, G, bid; };

struct TrJob { const float* src; const float* gain; bf16_t* dst; int N, Kd; int f8; };
DI void tr_load(float (&v)[32], const TrJob& j, int lane) {
#pragma unroll
    for (int i = 0; i < 32; ++i) { const int kk = 2 * i + (lane >> 5); v[i] = j.src[(size_t)kk * j.N + (lane & 31)]; }
}
DI void tr_store(const float (&v)[32], const TrJob& jb, LAS float* scr, int lane) {
#pragma unroll
    for (int i = 0; i < 32; ++i) { const int kk = 2 * i + (lane >> 5); scr[kk * 33 + (lane & 31)] = v[i]; }
    LDS_WAIT(); asm volatile("" ::: "memory");
    const int c = lane & 7;
    float g[8];
#pragma unroll
    for (int j = 0; j < 8; ++j) g[j] = jb.gain ? jb.gain[8 * c + j] : 1.0f;
#pragma unroll
    for (int j = 0; j < 4; ++j) { const int n = (lane >> 3) + 8 * j; const LAS float* s = scr + (8 * c) * 33 + n;
        float t[8];
#pragma unroll
        for (int q = 0; q < 8; ++q) t[q] = s[q * 33] * g[q];
        if (jb.f8) { u32x2 o; o.x = pk4_fp8(t[0] * 64.f, t[1] * 64.f, t[2] * 64.f, t[3] * 64.f); o.y = pk4_fp8(t[4] * 64.f, t[5] * 64.f, t[6] * 64.f, t[7] * 64.f);
            *(u32x2*)((unsigned char*)jb.dst + (size_t)n * jb.Kd + 8 * c) = o; }
        else { u32x4 o; o.x = cvt_pk_bf16(t[0], t[1]); o.y = cvt_pk_bf16(t[2], t[3]); o.z = cvt_pk_bf16(t[4], t[5]); o.w = cvt_pk_bf16(t[6], t[7]);
            *(u32x4*)(jb.dst + (size_t)n * jb.Kd + 8 * c) = o; } }
    LDS_WAIT(); asm volatile("" ::: "memory");
}
DI void p0_prologue(const Ctx& F, unsigned char* ws) {
    LAS float* scr = (LAS float*)(F.lds + F.wave * 8704);
    const int gw = F.bid * 8 + F.wave, NGW = F.G * 8;
    const int gt = F.bid * 512 + F.tid, NGT = F.G * 512;
    constexpr int I_IN = 32 * 128, I_G = 8 * 4 * 8, I_OUT = 32 * 64, I_QKV = 32 * 288, I_O = 16 * 64, I_PP = 4 * 64, I_PG = 32 * 64, I_ME = 512;
    constexpr int N_SMALL = I_IN + 2 * I_G + I_OUT + I_QKV + I_O + 2 * I_PP + 2 * I_PG;
    constexpr int N_ITEMS = N_SMALL + 3 * 128 * I_ME;
#define TR_DECODE(IT, JOB) do { int r = (IT); const float* src; int N; const float* gain = nullptr; bf16_t* dst; int Kd; int f8 = 0; \
        if (r < I_IN) { const int kb = r / 128, nb = r % 128; src = KF(A_W_IN) + (size_t)kb * 64 * 4096 + nb * 32; N = 4096; gain = KF(A_NORM_MIX) + kb * 64; if (MK_F8_PROJ) { dst = (bf16_t*)(ws + WS_W_IN + (size_t)nb * 32 * 2048 + kb * 64); f8 = 1; } else dst = (bf16_t*)(ws + WS_W_IN) + (size_t)nb * 32 * 2048 + kb * 64; Kd = 2048; } \
        else if ((r -= I_IN) < 2 * I_G) { const int ig = r / I_G; r %= I_G; const int blk = r / 32, kb = (r % 32) / 8, nb = r % 8; const int n0 = nb * 32; \
            src = (ig ? KF(A_W_IG) : KF(A_W_RG)) + (size_t)blk * 65536 + (size_t)kb * 64 * 256 + n0; N = 256; \
            const int drow = blk * 512 + (n0 >> 7) * 256 + ig * 128 + (n0 & 127); \
            dst = (bf16_t*)(ws + WS_W_G) + (size_t)drow * 256 + kb * 64; Kd = 256; } \
        else if ((r -= 2 * I_G) < I_OUT) { const int kb = r / 64, nb = r % 64; src = KF(A_W_OUT) + (size_t)kb * 64 * 2048 + nb * 32; N = 2048; if (MK_F8_WOUT) { dst = (bf16_t*)(ws + WS_W_OUT + (size_t)nb * 32 * 2048 + kb * 64); f8 = 1; } else dst = (bf16_t*)(ws + WS_W_OUT) + (size_t)nb * 32 * 2048 + kb * 64; Kd = 2048; } \
        else if ((r -= I_OUT) < I_QKV) { const int kb = r / 288, nb = r % 288; src = KF(A_W_QKV) + (size_t)kb * 64 * NQKV + nb * 32; N = NQKV; gain = KF(A_NORM_MIX) + DM + kb * 64; dst = (bf16_t*)(ws + WS_W_QKV + (size_t)nb * 32 * 2048 + kb * 64); Kd = 2048; f8 = 1; } \
        else if ((r -= I_QKV) < I_O) { const int kb = r / 64, nb = r % 64; src = KF(A_W_O) + (size_t)kb * 64 * 2048 + nb * 32; N = 2048; if (MK_F8_WO) { dst = (bf16_t*)(ws + WS_W_O + (size_t)nb * 32 * 1024 + kb * 64); f8 = 1; } else dst = (bf16_t*)(ws + WS_W_O) + (size_t)nb * 32 * 1024 + kb * 64; Kd = 1024; } \
        else if ((r -= I_O) < 2 * I_PP) { const int l = r / I_PP; r %= I_PP; const int kb = r / 64, nb = r % 64; \
            src = KF(A_PLE_PROJ) + (size_t)l * 256 * 2048 + (size_t)kb * 64 * 2048 + nb * 32; N = 2048; dst = (bf16_t*)(ws + WS_W_PP + (size_t)l * MiB) + (size_t)nb * 32 * 256 + kb * 64; Kd = 256; } \
        else if ((r -= 2 * I_PP) < 2 * I_PG) { const int l = r / I_PG; r %= I_PG; const int kb = r / 64, nb = r % 64; \
            src = KF(A_PLE_GATE) + (size_t)l * 2048 * 2048 + (size_t)kb * 64 * 2048 + nb * 32; N = 2048; if (MK_F8_PLEG) { dst = (bf16_t*)(ws + WS_W_PG + (size_t)l * 8 * MiB + (size_t)nb * 32 * 2048 + kb * 64); f8 = 1; } else dst = (bf16_t*)(ws + WS_W_PG + (size_t)l * 8 * MiB) + (size_t)nb * 32 * 2048 + kb * 64; Kd = 2048; } \
        else { r -= 2 * I_PG; const int mat = r / (128 * I_ME); r %= (128 * I_ME); const int le = r / I_ME, l = le >> 6, e = le & 63; r %= I_ME; \
          if (mat < 2) { \
              const int kb = r / 16, nb = r % 16, n0 = nb * 32; \
              src = (mat ? KF(A_W_UP) : KF(A_W_GATE)) + (size_t)le * 2048 * 512 + (size_t)kb * 64 * 512 + n0; N = 512; gain = KF(A_NORM_FFN) + l * DM + kb * 64; \
              const int drow = e * 1024 + (n0 >> 7) * 256 + mat * 128 + (n0 & 127); \
              dst = (bf16_t*)(ws + WS_W_GU + (size_t)l * 256 * MiB + (size_t)drow * 2048 + kb * 64); Kd = 2048; f8 = 1; \
          } else { \
              const int kb = r / 64, nb = r % 64; \
              src = KF(A_W_DOWN) + (size_t)le * 512 * 2048 + (size_t)kb * 64 * 2048 + nb * 32; N = 2048; dst = (bf16_t*)(ws + WS_W_D + (size_t)l * 128 * MiB + (size_t)(e * 2048 + nb * 32) * 512 + kb * 64); Kd = 512; f8 = 1; \
          } } \
        (JOB).src = src; (JOB).gain = gain; (JOB).dst = dst; (JOB).N = N; (JOB).Kd = Kd; (JOB).f8 = f8; } while (0)
    { int it = gw;
      if (it < N_ITEMS) {
        TrJob cur; TR_DECODE(it, cur);
        float v[32]; tr_load(v, cur, F.lane);
        for (;;) {
            const int nit = it + NGW; const bool hn = nit < N_ITEMS;
            TrJob nx = cur; float vn[32];
            if (hn) { TR_DECODE(nit, nx); tr_load(vn, nx, F.lane); }
            tr_store(v, cur, scr, F.lane);
            if (!hn) break;
            cur = nx; it = nit;
#pragma unroll
            for (int i = 0; i < 32; ++i) v[i] = vn[i];
        }
      } }
#undef TR_DECODE
    { const float* xin = KF(A_X);
    for (int row = gw; row < T; row += NGW) {
        const float* xr = xin + (size_t)row * DM + 8 * F.lane; bf16_t* ob = (bf16_t*)(ws + WS_HB) + (size_t)row * DM + 8 * F.lane;
        f32x4 v[8]; float ss = 0.f;
#pragma unroll
        for (int j = 0; j < 4; ++j) { v[2 * j] = *(const f32x4*)(xr + 512 * j); v[2 * j + 1] = *(const f32x4*)(xr + 512 * j + 4); }
#pragma unroll
        for (int j = 0; j < 8; ++j) ss += (v[j][0] * v[j][0] + v[j][1] * v[j][1]) + (v[j][2] * v[j][2] + v[j][3] * v[j][3]);
#pragma unroll
        for (int j = 0; j < 4; ++j) *(u32x4*)(ob + 512 * j) = pack8(v[2 * j], v[2 * j + 1]);
        if (MK_F8_PROJ) {
#pragma unroll
            for (int j = 0; j < 4; ++j) { u32x2 q; q.x = pk4_fp8(v[2 * j][0], v[2 * j][1], v[2 * j][2], v[2 * j][3]); q.y = pk4_fp8(v[2 * j + 1][0], v[2 * j + 1][1], v[2 * j + 1][2], v[2 * j + 1][3]); *(u32x2*)(ws + WS_H8 + (size_t)row * DM + 512 * j + 8 * F.lane) = q; } }
        ss = wave_sum(ss);
        if (F.lane == 0) ((rs_t*)(ws + WS_RSX))[row] = rs_fix(ss);
    } }
    { const float* pin = KF(A_P);
    for (int i = gt; i < 2 * T * PLE / 8; i += NGT) {
        const f32x4 a = *(const f32x4*)(pin + (size_t)i * 8), b = *(const f32x4*)(pin + (size_t)i * 8 + 4);
        *(u32x4*)((bf16_t*)(ws + WS_PB) + (size_t)i * 8) = pack8(a, b);
    } }
    for (int i = gt; i < DM; i += NGT) { const float l = KF(A_LAM)[i]; const float ls = fminf(l, 0.f) - log1pf(__expf(-fabsf(l))); ((float*)(ws + WS_CLAM))[i] = 8.0f * ls; }
    for (int i = gt; i < 2 * 256 * DM; i += NGT) {
        const int l = i / (256 * DM), rem = i % (256 * DM), n = rem / DM, k = rem % DM;
        float v = 0.f;
        if (n < 8) v = KF(A_W_GROUP)[(size_t)l * DM * 8 + (size_t)k * 8 + n];
        else if (n < 72) { const int g = (n - 8) >> 3, e = (n - 8) & 7; v = KF(A_W_EXPERT)[(size_t)l * 8 * DM * 8 + (size_t)g * DM * 8 + (size_t)k * 8 + e]; }
        v *= KF(A_NORM_FFN)[l * DM + k];
        ((bf16_t*)(ws + WS_W_R))[i] = (bf16_t)(cvt_pk_bf16(v, 0.f) & 0xffffu);
    }
}

DI void conv_phase(const Ctx& F, const bf16_t* proj, const float* cw, const float* cb, bf16_t* xc) {
    const int cg = F.tid & 255, sub = F.tid >> 8, ch = cg * 8;
    float w[4][8], b[8];
#pragma unroll
    for (int k = 0; k < 4; ++k)
#pragma unroll
        for (int j = 0; j < 8; ++j) w[k][j] = cw[k * DM + ch + j];
#pragma unroll
    for (int j = 0; j < 8; ++j) b[j] = cb[ch + j];
    for (int item = F.bid; item < T / 64; item += F.G) {
        const int t0 = item * 64 + sub * 32, s0 = t0 & (SEQ - 1);
        float x0[8], x1[8], x2[8];
#pragma unroll
        for (int j = 0; j < 8; ++j) { x0[j] = 0.f; x1[j] = 0.f; x2[j] = 0.f; }
        if (s0 >= 3) { unpack8(*(const u32x4*)(proj + (size_t)(t0 - 3) * 4096 + DM + ch), x0); unpack8(*(const u32x4*)(proj + (size_t)(t0 - 2) * 4096 + DM + ch), x1); unpack8(*(const u32x4*)(proj + (size_t)(t0 - 1) * 4096 + DM + ch), x2); }
#pragma unroll 8
        for (int i = 0; i < 32; ++i) {
            float x3[8]; unpack8(*(const u32x4*)(proj + (size_t)(t0 + i) * 4096 + DM + ch), x3);
            float y[8];
#pragma unroll
            for (int j = 0; j < 8; ++j) { y[j] = b[j] + w[0][j] * x0[j] + w[1][j] * x1[j] + w[2][j] * x2[j] + w[3][j] * x3[j]; x0[j] = x1[j]; x1[j] = x2[j]; x2[j] = x3[j]; }
            *(u32x4*)(xc + (size_t)(t0 + i) * DM + ch) = pack8((f32x4){y[0], y[1], y[2], y[3]}, (f32x4){y[4], y[5], y[6], y[7]});
        }
    }
}

DI void scanA_phase(const Ctx& F, const bf16_t* LA, const bf16_t* U, float* SP, float* SH) {
    const int ch = F.tid * 4;
    for (int item = F.bid; item < T / 128; item += F.G) {
        const size_t base = (size_t)item * 128 * DM + ch;
        float sl[4] = {0.f, 0.f, 0.f, 0.f}, h[4] = {0.f, 0.f, 0.f, 0.f};
#pragma unroll 8
        for (int i = 0; i < 128; ++i) {
            const u32x2 lw = *(const u32x2*)(LA + base + (size_t)i * DM), uw = *(const u32x2*)(U + base + (size_t)i * DM);
            const float l[4] = {bflo(lw.x), bfhi(lw.x), bflo(lw.y), bfhi(lw.y)}, uu[4] = {bflo(uw.x), bfhi(uw.x), bflo(uw.y), bfhi(uw.y)};
#pragma unroll
            for (int j = 0; j < 4; ++j) { sl[j] += l[j]; h[j] = __expf(l[j]) * h[j] + uu[j]; }
        }
        *(f32x4*)(SP + (size_t)item * DM + ch) = (f32x4){sl[0], sl[1], sl[2], sl[3]};
        *(f32x4*)(SH + (size_t)item * DM + ch) = (f32x4){h[0], h[1], h[2], h[3]};
    }
}
DI void scanB_phase(const Ctx& F, const float* SP, const float* SH, float* CIN) {
    const int gw = F.bid * 8 + F.wave, NGW = F.G * 8;
    for (int job = gw; job < NB * DM; job += NGW) {
        const int b = job / DM, ch = job % DM;
        const size_t i0 = ((size_t)(b * 128 + 2 * F.lane)) * DM + ch, i1 = i0 + DM;
        const float Pa = __expf(SP[i0]), Ha = SH[i0], Pb = __expf(SP[i1]), Hb = SH[i1];
        float Pc = Pa * Pb, Hc = Pb * Ha + Hb;
#pragma unroll
        for (int off = 1; off < 64; off <<= 1) {
            const float Pp = __shfl_up(Pc, off), Hp = __shfl_up(Hc, off);
            if (F.lane >= off) { Hc = Pc * Hp + Hc; Pc = Pc * Pp; }
        }
        float ex = __shfl_up(Hc, 1); if (F.lane == 0) ex = 0.f;
        CIN[i0] = ex; CIN[i1] = Pa * ex + Ha;
    }
}
DI float gelu_tanh(float x) { const float z = 0.7978845608028654f * (x + 0.044715f * x * x * x); const float e = __expf(2.0f * z); const float th = 1.0f - 2.0f / (e + 1.0f); return 0.5f * x * (1.0f + th); }
template <bool F8> DI void scanC_phase(const Ctx& F, const bf16_t* LA, const bf16_t* U, const bf16_t* proj, const float* CIN, bf16_t* Y) {
    const int ch = F.tid * 4;
    for (int item = F.bid; item < T / 128; item += F.G) {
        const size_t base = (size_t)item * 128 * DM + ch;
        const f32x4 c = *(const f32x4*)(CIN + (size_t)item * DM + ch);
        float h[4] = {c[0], c[1], c[2], c[3]};
#pragma unroll 8
        for (int i = 0; i < 128; ++i) {
            const u32x2 lw = *(const u32x2*)(LA + base + (size_t)i * DM), uw = *(const u32x2*)(U + base + (size_t)i * DM);
            const u32x2 gw = *(const u32x2*)(proj + ((size_t)item * 128 + i) * 4096 + ch);
            const float l[4] = {bflo(lw.x), bfhi(lw.x), bflo(lw.y), bfhi(lw.y)}, uu[4] = {bflo(uw.x), bfhi(uw.x), bflo(uw.y), bfhi(uw.y)}, gg[4] = {bflo(gw.x), bfhi(gw.x), bflo(gw.y), bfhi(gw.y)};
            float y[4];
#pragma unroll
            for (int j = 0; j < 4; ++j) { h[j] = __expf(l[j]) * h[j] + uu[j]; y[j] = gelu_tanh(gg[j]) * h[j]; }
            if constexpr (F8) *(unsigned*)((unsigned char*)Y + base + (size_t)i * DM) = pk4_fp8(y[0] * 8.f, y[1] * 8.f, y[2] * 8.f, y[3] * 8.f);
            else { u32x2 o; o.x = cvt_pk_bf16(y[0], y[1]); o.y = cvt_pk_bf16(y[2], y[3]); *(u32x2*)(Y + base + (size_t)i * DM) = o; }
        }
    }
}

DI void route_phase(const Ctx& F, const float* logits, const float* b_group, const float* b_expert, unsigned* gcount, int* slot_aid, float* slot_gate) {
    LAS unsigned* hist = (LAS unsigned*)(F.lds + MISC_OFF + MO_HIST); LAS unsigned* base = hist + 64;
    for (int blk = F.bid; blk < T / 128; blk += F.G) {
        if (F.tid < 64) hist[F.tid] = 0u;
        __syncthreads();
        const int t = blk * 128 + F.tid;
        int e0 = 0, e1 = 0; float g0 = 0.f, g1 = 0.f; unsigned r0 = 0u, r1 = 0u;
        if (F.tid < 128) {
            const float* lp = logits + (size_t)t * 128;
            const f32x4 a = *(const f32x4*)lp, b = *(const f32x4*)(lp + 4);
            float lg[8] = {a[0], a[1], a[2], a[3], b[0], b[1], b[2], b[3]};
            int gi = 0; float gm = -3.0e38f;
#pragma unroll
            for (int j = 0; j < 8; ++j) { lg[j] += b_group[j]; if (lg[j] > gm) { gm = lg[j]; gi = j; } }
            float den = 0.f;
#pragma unroll
            for (int j = 0; j < 8; ++j) den += __expf(lg[j] - gm);
            const float ptop = 1.0f / den;
            const f32x4 c = *(const f32x4*)(lp + 8 + gi * 8), d = *(const f32x4*)(lp + 12 + gi * 8);
            float le[8] = {c[0], c[1], c[2], c[3], d[0], d[1], d[2], d[3]};
            int i1 = 0; float v1 = -3.0e38f;
#pragma unroll
            for (int j = 0; j < 8; ++j) { le[j] += b_expert[gi * 8 + j]; if (le[j] > v1) { v1 = le[j]; i1 = j; } }
            int i2 = 0; float v2 = -3.0e38f;
#pragma unroll
            for (int j = 0; j < 8; ++j) { if (j != i1 && le[j] > v2) { v2 = le[j]; i2 = j; } }
            const float w1 = 1.0f / (1.0f + __expf(v2 - v1)), w2 = 1.0f - w1;
            e0 = gi * 8 + i1; e1 = gi * 8 + i2; g0 = ptop * w1; g1 = ptop * w2;
            r0 = __hip_atomic_fetch_add(hist + e0, 1u, __ATOMIC_RELAXED, __HIP_MEMORY_SCOPE_WORKGROUP);
            r1 = __hip_atomic_fetch_add(hist + e1, 1u, __ATOMIC_RELAXED, __HIP_MEMORY_SCOPE_WORKGROUP);
        }
        __syncthreads();
        if (F.tid < 64) { const unsigned c = hist[F.tid]; base[F.tid] = c ? __hip_atomic_fetch_add(gcount + F.tid, c, __ATOMIC_RELAXED, __HIP_MEMORY_SCOPE_AGENT) : 0u; }
        __syncthreads();
        if (F.tid < 128) {
            const unsigned p0 = base[e0] + r0, p1 = base[e1] + r1;
            slot_aid[e0 * SLOTCAP + p0] = 2 * t; slot_gate[e0 * SLOTCAP + p0] = g0;
            slot_aid[e1 * SLOTCAP + p1] = 2 * t + 1; slot_gate[e1 * SLOTCAP + p1] = g1;
        }
        __syncthreads();
    }
}
DI void moe_tables(const Ctx& F, unsigned* gcount) {
    LAS int* cnt = (LAS int*)(F.lds + MISC_OFF + MO_CNT); LAS int* mtpre = (LAS int*)(F.lds + MISC_OFF + MO_MTPRE); LAS unsigned char* t2e = F.lds + MISC_OFF + MO_T2E;
    if (F.tid < 64) cnt[F.tid] = (int)__hip_atomic_load(gcount + F.tid, __ATOMIC_RELAXED, __HIP_MEMORY_SCOPE_AGENT);
    __syncthreads();
    if (F.tid == 0) { int s = 0; for (int e = 0; e < 64; ++e) { mtpre[e] = s; s += (cnt[e] + 255) >> 8; } mtpre[64] = s; }
    __syncthreads();
    if (F.tid < 64) { const int a = mtpre[F.tid], b = mtpre[F.tid + 1]; for (int m = a; m < b && m < 384; ++m) t2e[m] = (unsigned char)F.tid; }
    __syncthreads();
}

template <bool F8> DI void combine_phase(const Ctx& F, const unsigned char* yb, bf16_t* hb, unsigned char* h8) {
    const int gw = F.bid * 8 + F.wave, NGW = F.G * 8;
    for (int row = gw; row < T; row += NGW) {
        const unsigned char* y0 = yb + (size_t)(2 * row) * DM + 8 * F.lane; const unsigned char* y1 = y0 + DM; bf16_t* hrow = hb + (size_t)row * DM + 8 * F.lane;
        u32x4 hw[4]; u32x2 a0[4], a1[4];
#pragma unroll
        for (int j = 0; j < 4; ++j) { hw[j] = *(const u32x4*)(hrow + 512 * j); a0[j] = *(const u32x2*)(y0 + 512 * j); a1[j] = *(const u32x2*)(y1 + 512 * j); }
#pragma unroll
        for (int j = 0; j < 4; ++j) {
            float h[8], v0[8], v1[8]; unpack8(hw[j], h); unpack8_fp8(a0[j], v0); unpack8_fp8(a1[j], v1);
#pragma unroll
            for (int k = 0; k < 8; ++k) h[k] += (v0[k] + v1[k]) * (1.0f / 16.0f);
            *(u32x4*)(hrow + 512 * j) = pack8((f32x4){h[0], h[1], h[2], h[3]}, (f32x4){h[4], h[5], h[6], h[7]});
            if constexpr (F8) { u32x2 q; q.x = pk4_fp8(h[0], h[1], h[2], h[3]); q.y = pk4_fp8(h[4], h[5], h[6], h[7]); *(u32x2*)(h8 + (size_t)row * DM + 512 * j + 8 * F.lane) = q; }
        }
    }
}
DI void finish_phase(const Ctx& F, float* out, const bf16_t* eg, const rs_t* rowss_eg, const float* gain, bf16_t* hb, unsigned char* h8, rs_t* rowss_next, bool last) {
    const int gw = F.bid * 8 + F.wave, NGW = F.G * 8;
    float gn[4][8];
#pragma unroll
    for (int j = 0; j < 4; ++j)
#pragma unroll
        for (int k = 0; k < 8; ++k) gn[j][k] = gain[512 * j + 8 * F.lane + k];
    for (int row = gw; row < T; row += NGW) {
        float* orow = out + (size_t)row * DM + 8 * F.lane; const bf16_t* erow = eg + (size_t)row * DM + 8 * F.lane; bf16_t* hrow = hb + (size_t)row * DM + 8 * F.lane;
        u32x4 hw[4], ew[4];
#pragma unroll
        for (int j = 0; j < 4; ++j) { hw[j] = *(const u32x4*)(hrow + 512 * j); ew[j] = *(const u32x4*)(erow + 512 * j); }
        const float rs = rs_rstd(rowss_eg[row]);
        float ss = 0.f;
#pragma unroll
        for (int j = 0; j < 4; ++j) {
            float h[8], ev[8]; unpack8(hw[j], h); unpack8(ew[j], ev);
#pragma unroll
            for (int k = 0; k < 8; ++k) { h[k] += ev[k] * rs * gn[j][k]; ss += h[k] * h[k]; }
            if (last) { *(f32x4*)(orow + 512 * j) = (f32x4){h[0], h[1], h[2], h[3]}; *(f32x4*)(orow + 512 * j + 4) = (f32x4){h[4], h[5], h[6], h[7]}; }
            else { *(u32x4*)(hrow + 512 * j) = pack8((f32x4){h[0], h[1], h[2], h[3]}, (f32x4){h[4], h[5], h[6], h[7]});
                   u32x2 q; q.x = pk4_fp8(h[0], h[1], h[2], h[3]); q.y = pk4_fp8(h[4], h[5], h[6], h[7]); *(u32x2*)(h8 + (size_t)row * DM + 512 * j + 8 * F.lane) = q; }
        }
        if (!last) { ss = wave_sum(ss); if (F.lane == 0) rowss_next[row] = rs_fix(ss); }
    }
}

DI int k_off(int row, int chunk) { return row * 256 + ((chunk ^ (row & 15)) << 4); }
DI int v_off(int row, int chunk) { return row * 256 + ((chunk ^ ((row & 7) << 1)) << 4); }
struct AUnit { int g, head, d, n; size_t tok0, prow0; };
DI void attn_decode_seg(int sid, int u, AUnit& U) {
    const int g = sid >> 8, idx = sid & 255, head = idx & 7, rest = idx >> 3;
    const int dsh = 2 * g, nsc = 16 >> dsh, chain = rest / nsc, b = chain >> dsh, r = chain & ((1 << dsh) - 1);
    U.g = g; U.head = head; U.d = 1 << dsh; U.n = (rest % nsc) * 8 + u; U.tok0 = (size_t)b * SEQ + r;
    U.prow0 = (size_t)b * SEQ + (size_t)r * (SEQ >> dsh);
}
#define ATT_PLANE(U_, s_) (qkv + (((size_t)((U_).g * 3 + (s_)) * 8 + (U_).head) * T) * HD)
#define ATT_LOADS(U_, first_) do { \
    _Pragma("unroll") for (int ps = 0; ps < 8; ++ps) { if ((first_) || ps >= 4) { const int j_ = 128 * ((U_).n - 1) + ps * 32 + rowi; kraw[ps] = (u32x2){0u, 0u}; vraw[ps] = (u32x2){0u, 0u}; kpos[ps] = 0; \
        if (j_ >= 0) { const size_t ro_ = ((U_).prow0 + (size_t)j_) * HD + chunk * 8; kraw[ps] = *(const u32x2*)(ATT_PLANE(U_, 1) + ro_); vraw[ps] = *(const u32x2*)(ATT_PLANE(U_, 2) + ro_); \
                       kpos[ps] = positions[(U_).tok0 + (size_t)j_ * (U_).d]; } } } \
    { const int jq_ = 128 * (U_).n + 16 * w + q16; \
      _Pragma("unroll") for (int dk = 0; dk < 4; ++dk) qraw[dk] = *(const u32x2*)(ATT_PLANE(U_, 0) + ((U_).prow0 + (size_t)jq_) * HD + dk * 32 + 8 * gq); \
      qpos = positions[(U_).tok0 + (size_t)jq_ * (U_).d]; } \
    } while (0)
DI float rope_rev_const(int i) { return __builtin_amdgcn_exp2f(-(float)i * 0.20762050593046014f) * 0.15915494309189535f; }
DI void attn_phase(const Ctx& F, const unsigned char* qkv, const float* q_gain, const float* k_gain, const int* positions, bf16_t* og, float* lse) {
    LAS unsigned char* Ks = F.lds; LAS unsigned char* Vs = F.lds + 65536;
    const int lane = F.lane, w = F.wave, q16 = lane & 15, gq = lane >> 4;
    const int chunk = F.tid & 15, rowi = F.tid >> 4, ci = 8 * (chunk & 7);
    const int nseg = (768 - F.bid + F.G - 1) / F.G, nsteps = nseg * 8;
    if (F.bid >= 768) return;
    int st = 0;
    AUnit U, Un; attn_decode_seg(F.bid, 0, U);
    u32x2 kraw[8], vraw[8], qraw[4]; int kpos[8], qpos;
#pragma unroll
    for (int ps = 0; ps < 8; ++ps) { kraw[ps] = (u32x2){0u, 0u}; vraw[ps] = (u32x2){0u, 0u}; kpos[ps] = 0; }
    ATT_LOADS(U, true);
    for (;;) {
        const int g = U.g, head = U.head, n = U.n;
        const bool first = (st & 7) == 0;
        {
            float kg[8]; { const f32x4 a = *(const f32x4*)(k_gain + g * HD + 8 * chunk), c = *(const f32x4*)(k_gain + g * HD + 8 * chunk + 4);
#pragma unroll
                for (int k = 0; k < 4; ++k) { kg[k] = a[k]; kg[4 + k] = c[k]; } }
            float kc[8];
#pragma unroll
            for (int k = 0; k < 8; ++k) kc[k] = rope_rev_const(ci + k);
#pragma unroll
            for (int ps = 0; ps < 8; ++ps) {
                if (first || ps >= 4) {
                    const int krow = ps * 32 + rowi;
                    if (!first) {
                        const u32x4 tk = *(const LAS u32x4*)(Ks + k_off(krow, chunk)), tv = *(const LAS u32x4*)(Vs + v_off(krow, chunk));
                        *(LAS u32x4*)(Ks + k_off(krow - 128, chunk)) = tk; *(LAS u32x4*)(Vs + v_off(krow - 128, chunk)) = tv; }
                    float v[8]; unpack8_fp8(kraw[ps], v);
                    float ss = 0.f;
#pragma unroll
                    for (int k = 0; k < 8; ++k) ss += v[k] * v[k];
                    ss = row16_sum(ss);
                    const float rs = __builtin_amdgcn_rsqf(ss * (1.0f / HD) + EPS);
                    float pv[8], o[8];
#pragma unroll
                    for (int k = 0; k < 8; ++k) v[k] = v[k] * rs * kg[k];
#pragma unroll
                    for (int k = 0; k < 8; ++k) pv[k] = row16_xor8(v[k]);
                    const float fp = (float)kpos[ps];
#pragma unroll
                    for (int k = 0; k < 8; ++k) { const float rev = fp * kc[k], fr = rev - __builtin_rintf(rev); const float c = __builtin_amdgcn_cosf(fr), sn = __builtin_amdgcn_sinf(fr);
                        o[k] = (chunk < 8) ? (v[k] * c - pv[k] * sn) : (v[k] * c + pv[k] * sn); }
                    *(LAS u32x4*)(Ks + k_off(krow, chunk)) = pack8((f32x4){o[0], o[1], o[2], o[3]}, (f32x4){o[4], o[5], o[6], o[7]});
                    float vv[8]; unpack8_fp8(vraw[ps], vv);
                    *(LAS u32x4*)(Vs + v_off(krow, chunk)) = pack8((f32x4){vv[0], vv[1], vv[2], vv[3]}, (f32x4){vv[4], vv[5], vv[6], vv[7]});
                }
            }
        }
        const size_t pq = U.prow0 + (size_t)(128 * n + 16 * w + q16);
        bf16x8 qf[4];
        {
            float qv[4][8];
#pragma unroll
            for (int dk = 0; dk < 4; ++dk) unpack8_fp8(qraw[dk], qv[dk]);
            float ss = 0.f;
#pragma unroll
            for (int dk = 0; dk < 4; ++dk)
#pragma unroll
                for (int k = 0; k < 8; ++k) ss += qv[dk][k] * qv[dk][k];
            ss += __shfl_xor(ss, 16); ss += __shfl_xor(ss, 32);
            const float rs = __builtin_amdgcn_rsqf(ss * (1.0f / HD) + EPS);
#pragma unroll
            for (int dk = 0; dk < 4; ++dk) { const f32x4 ga = *(const f32x4*)(q_gain + g * HD + dk * 32 + 8 * gq), gb = *(const f32x4*)(q_gain + g * HD + dk * 32 + 8 * gq + 4);
#pragma unroll
                for (int k = 0; k < 4; ++k) { qv[dk][k] *= rs * ga[k]; qv[dk][4 + k] *= rs * gb[k]; } }
#pragma unroll
            for (int dk = 0; dk < 2; ++dk) {
                const float fp = (float)qpos;
#pragma unroll
                for (int k = 0; k < 8; ++k) { const float rev = fp * rope_rev_const(32 * dk + 8 * gq + k), fr = rev - __builtin_rintf(rev); const float c = __builtin_amdgcn_cosf(fr), sn = __builtin_amdgcn_sinf(fr);
                    const float t1 = qv[dk][k], t2 = qv[dk + 2][k]; qv[dk][k] = t1 * c - t2 * sn; qv[dk + 2][k] = t2 * c + t1 * sn; }
            }
#pragma unroll
            for (int dk = 0; dk < 4; ++dk) qf[dk] = __builtin_bit_cast(bf16x8, pack8((f32x4){qv[dk][0], qv[dk][1], qv[dk][2], qv[dk][3]}, (f32x4){qv[dk][4], qv[dk][5], qv[dk][6], qv[dk][7]}));
        }
        asm volatile("" : "+v"(qf[0]), "+v"(qf[1]), "+v"(qf[2]), "+v"(qf[3]) :: "memory");
        __syncthreads();
        const int nst = st + 1; const bool hn = nst < nsteps;
        if (hn) { attn_decode_seg(F.bid + (nst >> 3) * F.G, nst & 7, Un); const bool nfirst = (nst & 7) == 0; ATT_LOADS(Un, nfirst); }
        __builtin_amdgcn_sched_barrier(0);
        f32x4 s[9];
#pragma unroll
        for (int i = 0; i < 9; ++i) {
            f32x4 a = {0.f, 0.f, 0.f, 0.f};
            const int krow = 16 * (w + i) + q16;
#pragma unroll
            for (int dk = 0; dk < 4; ++dk) { const bf16x8 kf = *(const LAS bf16x8*)(Ks + k_off(krow, 4 * dk + gq)); a = __builtin_amdgcn_mfma_f32_16x16x32_bf16(kf, qf[dk], a, 0, 0, 0); }
            s[i] = a;
        }
        constexpr float C2 = 0.08838834764831845f * 1.4426950408889634f;
        float mx = -3.0e38f;
#pragma unroll
        for (int i = 0; i < 9; ++i)
#pragma unroll
            for (int rg = 0; rg < 4; ++rg) {
                const int dlt = 16 * i + 4 * gq + rg - q16;
                bool ok = (dlt >= 0) && (dlt <= 128);
                if (n == 0 && (w + i) < 8) ok = false;
                const float v = ok ? s[i][rg] * C2 : -1.0e30f;
                s[i][rg] = v; mx = fmaxf(mx, v);
            }
        mx = fmaxf(mx, __shfl_xor(mx, 16)); mx = fmaxf(mx, __shfl_xor(mx, 32));
        float den = 0.f;
#pragma unroll
        for (int i = 0; i < 9; ++i)
#pragma unroll
            for (int rg = 0; rg < 4; ++rg) { const float p = __builtin_amdgcn_exp2f(s[i][rg] - mx); s[i][rg] = p; den += p; }
        den += __shfl_xor(den, 16); den += __shfl_xor(den, 32);
        f32x4 o[8];
#pragma unroll
        for (int db = 0; db < 8; ++db) o[db] = (f32x4){0.f, 0.f, 0.f, 0.f};
#pragma unroll
        for (int t5 = 0; t5 < 5; ++t5) {
            const int i0 = 2 * t5, i1 = (t5 < 4) ? 2 * t5 + 1 : 8;
            const f32x4 p0 = s[i0], p1 = (t5 < 4) ? s[i1] : (f32x4){0.f, 0.f, 0.f, 0.f};
            const u32x4 pw = pack8(p0, p1); const bf16x8 pb = __builtin_bit_cast(bf16x8, pw);
            const int row0 = 16 * (w + i0) + 4 * gq + (q16 >> 2), row1 = 16 * (w + i1) + 4 * gq + (q16 >> 2);
#pragma unroll
            for (int db = 0; db < 8; ++db) {
                const int vch = 2 * db + ((q16 & 3) >> 1), sub8 = (q16 & 1) * 8;
                const s16x4 lo = __builtin_amdgcn_ds_read_tr16_b64_v4i16((LAS s16x4*)(Vs + v_off(row0, vch) + sub8));
                const s16x4 hi = __builtin_amdgcn_ds_read_tr16_b64_v4i16((LAS s16x4*)(Vs + v_off(row1, vch) + sub8));
                const bf16x8 vf = __builtin_shufflevector(lo, hi, 0, 1, 2, 3, 4, 5, 6, 7);
                o[db] = __builtin_amdgcn_mfma_f32_16x16x32_bf16(vf, pb, o[db], 0, 0, 0);
            }
        }
        const float inv = 1.0f / den;
        bf16_t* orow = og + (((size_t)g * NHEAD + head) * T + pq) * HD + 4 * gq;
#pragma unroll
        for (int db = 0; db < 8; ++db) { u32x2 ow; ow.x = cvt_pk_bf16(o[db][0] * inv, o[db][1] * inv); ow.y = cvt_pk_bf16(o[db][2] * inv, o[db][3] * inv); *(u32x2*)(orow + 16 * db) = ow; }
        if (gq == 0) lse[((size_t)g * NHEAD + head) * T + pq] = (mx + __builtin_amdgcn_logf(den)) * 0.6931471805599453f;
        __syncthreads();
        if (!hn) break;
        U = Un; st = nst;
    }
}
#undef ATT_LOADS
#undef ATT_PLANE
template <bool F8> DI void merge_phase(const Ctx& F, const bf16_t* og, const float* lse, bf16_t* ob) {
    const int gt = F.bid * 512 + F.tid, NGT = F.G * 512;
    for (int i = gt; i < T * 128; i += NGT) {
        const int t = i >> 7, c8 = i & 127, head = c8 >> 4;
        const size_t p0 = g8::qkv_plane_row(t, 0), p1 = g8::qkv_plane_row(t, 2), p2 = g8::qkv_plane_row(t, 4);
        const float l0 = lse[((size_t)0 * NHEAD + head) * T + p0], l1 = lse[((size_t)1 * NHEAD + head) * T + p1], l2 = lse[((size_t)2 * NHEAD + head) * T + p2];
        const float m = fmaxf(l0, fmaxf(l1, l2));
        float w0 = __expf(l0 - m), w1 = __expf(l1 - m), w2 = __expf(l2 - m); const float inv = 1.0f / (w0 + w1 + w2); w0 *= inv; w1 *= inv; w2 *= inv;
        float a[8], b[8], c[8];
        const int dd = (c8 & 15) * 8;
        unpack8(*(const u32x4*)(og + (((size_t)0 * NHEAD + head) * T + p0) * HD + dd), a); unpack8(*(const u32x4*)(og + (((size_t)1 * NHEAD + head) * T + p1) * HD + dd), b); unpack8(*(const u32x4*)(og + (((size_t)2 * NHEAD + head) * T + p2) * HD + dd), c);
        float o[8];
#pragma unroll
        for (int k = 0; k < 8; ++k) o[k] = w0 * a[k] + w1 * b[k] + w2 * c[k];
        if constexpr (F8) { u32x2 q; q.x = pk4_fp8(o[0] * 16.f, o[1] * 16.f, o[2] * 16.f, o[3] * 16.f); q.y = pk4_fp8(o[4] * 16.f, o[5] * 16.f, o[6] * 16.f, o[7] * 16.f); *(u32x2*)((unsigned char*)ob + (size_t)t * 1024 + c8 * 8) = q; }
        else *(u32x4*)(ob + (size_t)t * 1024 + c8 * 8) = pack8((f32x4){o[0], o[1], o[2], o[3]}, (f32x4){o[4], o[5], o[6], o[7]});
    }
}

struct Args { const void* in[28]; float* out; unsigned char* ws; int ph_lo, ph_hi; };

__global__ void __launch_bounds__(512, 2) mk_fwd(Args args) {
    extern __shared__ __attribute__((aligned(16))) unsigned char lds_raw[];
    Ctx F; F.lds = (LAS unsigned char*)lds_raw; F.G = gridDim.x; F.bid = blockIdx.x;
    int wave_s = __builtin_amdgcn_readfirstlane((int)threadIdx.x >> 6); asm volatile("" : "+s"(wave_s));
#define RF() do { int l_ = (int)__builtin_amdgcn_mbcnt_hi(~0u, __builtin_amdgcn_mbcnt_lo(~0u, 0u)); asm volatile("" : "+v"(l_)); F.lane = l_; F.wave = wave_s; F.tid = wave_s * 64 + l_; } while (0)
    RF();
    unsigned char* ws = (unsigned char*)karg_ptr(A_WS);
    unsigned* ctl = (unsigned*)(ws + WS_CTL);
    for (int u = F.tid; u < (LDS_BYTES - MISC_OFF) / 4; u += 512) ((LAS unsigned*)(F.lds + MISC_OFF))[u] = 0u;
    __syncthreads();
    XcdBarrier bar; bar.bar = ctl + CW_BAR; bar.x = 0; bar.st = nullptr;
    if (N_LAUNCHES == 1) bar = xcd_barrier_post(ctl + CW_BAR, (volatile LAS unsigned*)(F.lds + MISC_OFF + MO_BARW), F.tid);
    const int lo = args.ph_lo, hi = args.ph_hi;
#define IN(k) (lo <= (k) && (k) < hi)
#define SEAM(k) do { if (IN((k) + 1)) { RF(); if (N_LAUNCHES == 1) xcd_barrier(bar, F.tid); } } while (0)

    bf16_t* HB = (bf16_t*)(ws + WS_HB);
    rs_t* rowss_acc = (rs_t*)(ctl + CW_ROWSS);
    rs_t* RSX = (rs_t*)(ws + WS_RSX); rs_t* RSH3 = (rs_t*)(ws + WS_RSH3);
    LAS unsigned char* ring = F.lds;

    if (IN(0)) { RF(); for (int rep = 0; rep < ((MK_DUP & 1) ? 2 : 1); ++rep) p0_prologue(F, ws); SEAM(0); }
    if (IN(1)) { RF();
        constexpr bool F8 = MK_F8_PROJ != 0; constexpr unsigned LD = F8 ? DM : DM * 2;
        g8::StaticSched S; S.init(F8 ? (const void*)(ws + WS_H8) : (const void*)HB, LD, ws + WS_W_IN, LD, T / 256, 4096 / 256, F.G, F.bid);
        g8::EpiBf16ScaleT<F8> E{(bf16_t*)(ws + WS_PROJ), 4096, RSX, F8 ? 1.0f / 64.0f : 1.0f};
        for (int rep = 0; rep < ((MK_DUP & 1024) ? 2 : 1); ++rep) g8::gemm_phase(ring, F.tid, F8 ? DM / 2 : DM, LD, LD, S, E);
        SEAM(1);
    }
    if (IN(2)) { RF(); for (int rep = 0; rep < ((MK_DUP & 512) ? 2 : 1); ++rep) conv_phase(F, (const bf16_t*)(ws + WS_PROJ), KF(A_CONV_W), KF(A_CONV_B), (bf16_t*)(ws + WS_XC)); SEAM(2); }
    if (IN(3)) { RF();
        g8::GateSched S; S.init(ws + WS_XC, ws + WS_W_G, F.G, F.bid);
        g8::EpiGates E{(const bf16_t*)(ws + WS_XC), KF(A_B_RG), KF(A_B_IG), (const float*)(ws + WS_CLAM), (bf16_t*)(ws + WS_LA), (bf16_t*)(ws + WS_U)};
        for (int rep = 0; rep < ((MK_DUP & 4096) ? 2 : 1); ++rep) g8::gemm_phase(ring, F.tid, 256, DM * 2, 256 * 2, S, E);
        SEAM(3);
    }
    if (IN(4)) { RF(); for (int rep = 0; rep < ((MK_DUP & 512) ? 2 : 1); ++rep) scanA_phase(F, (const bf16_t*)(ws + WS_LA), (const bf16_t*)(ws + WS_U), (float*)(ws + WS_SP), (float*)(ws + WS_SH)); SEAM(4); }
    if (IN(5)) { RF(); for (int rep = 0; rep < ((MK_DUP & 512) ? 2 : 1); ++rep) scanB_phase(F, (const float*)(ws + WS_SP), (const float*)(ws + WS_SH), (float*)(ws + WS_CIN)); SEAM(5); }
    if (IN(6)) { RF(); for (int rep = 0; rep < ((MK_DUP & 512) ? 2 : 1); ++rep) scanC_phase<MK_F8_WOUT != 0>(F, (const bf16_t*)(ws + WS_LA), (const bf16_t*)(ws + WS_U), (const bf16_t*)(ws + WS_PROJ), (const float*)(ws + WS_CIN), (bf16_t*)(ws + WS_XC)); SEAM(6); }
    if (IN(7)) { RF();
        constexpr bool F8 = MK_F8_WOUT != 0; constexpr unsigned LD = F8 ? DM : DM * 2;
        g8::StaticSched S; S.init(ws + WS_XC, LD, ws + WS_W_OUT, LD, T / 256, DM / 256, F.G, F.bid);
        g8::EpiResidT<F8> E{HB, ws + WS_H8, rowss_acc + 0 * T, F8 ? 1.0f / (64.0f * 8.0f) : 1.0f};
        g8::gemm_phase(ring, F.tid, F8 ? DM / 2 : DM, LD, LD, S, E); SEAM(7);
    }
#define MOE_LAYER(PH, L, RS_H, RS_EG, RS_NEXT, LAST) \
    if (IN(PH)) { RF();   \
        { g8::StaticSched S; S.init(HB, DM * 2, ws + WS_W_R + (size_t)(L) * MiB, DM * 2, T / 256, 1, F.G, F.bid); \
          g8::EpiLogits E{(float*)(ws + WS_LOGITS), RS_H}; g8::gemm_phase(ring, F.tid, DM, DM * 2, DM * 2, S, E); } \
        { g8::StaticSched S; S.init(ws + WS_PB + (size_t)(L) * T * PLE * 2, PLE * 2, ws + WS_W_PP + (size_t)(L) * MiB, PLE * 2, T / 256, DM / 256, F.G, F.bid); \
          if (F.G == 256) { if (F.bid < 128) S.deal(512, F.bid, 1); else S.deal(512, 128 + (F.bid - 128) * 3, 3); }     \
          g8::EpiBf16Scale E{(bf16_t*)(ws + WS_EG), DM, nullptr, 1.0f}; g8::gemm_phase(ring, F.tid, PLE, PLE * 2, PLE * 2, S, E); } \
        SEAM(PH); } \
    if (IN((PH) + 1)) { RF(); route_phase(F, (const float*)(ws + WS_LOGITS), KF(A_B_GROUP) + (L) * 8, KF(A_B_EXPERT) + (L) * 64, ctl + CW_CNT + (L) * 64, (int*)(ws + WS_SLOT_AID), (float*)(ws + WS_SLOT_GATE)); SEAM((PH) + 1); } \
    if (IN((PH) + 2)) { RF(); moe_tables(F, ctl + CW_CNT + (L) * 64); \
        g8::MoeSched<4, true> S; S.init(ws + WS_H8, DM, ws + WS_W_GU + (size_t)(L) * 256 * MiB, DM, (size_t)1024 * DM, (const int*)(ws + WS_SLOT_AID), F.lds + MISC_OFF, F.G, F.bid); \
        g8::EpiGU E{ws + WS_HID, (const int*)(ws + WS_SLOT_AID), RS_H}; for (int rep = 0; rep < ((MK_DUP & 8) ? 2 : 1); ++rep) g8::gemm_phase(ring, F.tid, DM / 2, DM, DM, S, E); SEAM((PH) + 2); } \
    if (IN((PH) + 3)) { RF(); moe_tables(F, ctl + CW_CNT + (L) * 64); \
        g8::MoeSched<8, false> S; S.init(ws + WS_HID, DEXP, ws + WS_W_D + (size_t)(L) * 128 * MiB, DEXP, (size_t)DM * DEXP, (const int*)(ws + WS_SLOT_AID), F.lds + MISC_OFF, F.G, F.bid); \
        g8::EpiDown E{ws + WS_YB, (const int*)(ws + WS_SLOT_AID), (const float*)(ws + WS_SLOT_GATE)}; for (int rep = 0; rep < ((MK_DUP & 16) ? 2 : 1); ++rep) g8::gemm_phase(ring, F.tid, DEXP / 2, DEXP, DEXP, S, E); SEAM((PH) + 3); } \
    if (IN((PH) + 4)) { RF(); combine_phase<MK_F8_PLEG != 0>(F, ws + WS_YB, HB, ws + WS_H8); SEAM((PH) + 4); } \
    if (IN((PH) + 5)) { RF(); constexpr bool F8 = MK_F8_PLEG != 0; constexpr unsigned LD = F8 ? DM : DM * 2; \
        g8::StaticSched S; S.init(F8 ? (const void*)(ws + WS_H8) : (const void*)HB, LD, ws + WS_W_PG + (size_t)(L) * 8 * MiB, LD, T / 256, DM / 256, F.G, F.bid); \
        g8::EpiPleGT<F8> E{(bf16_t*)(ws + WS_EG), RS_EG, F8 ? 1.0f / 64.0f : 1.0f}; g8::gemm_phase(ring, F.tid, F8 ? DM / 2 : DM, LD, LD, S, E); SEAM((PH) + 5); } \
    if (IN((PH) + 6)) { RF(); finish_phase(F, (float*)karg_ptr(A_OUT), (const bf16_t*)(ws + WS_EG), RS_EG, KF(A_PLE_NORM) + (L) * DM, HB, ws + WS_H8, RS_NEXT, LAST); SEAM((PH) + 6); }

    MOE_LAYER(8, 0, rowss_acc + 0 * T, rowss_acc + 1 * T, RSH3, false)
    if (IN(15)) { RF();
        g8::StaticSched S; S.init(ws + WS_H8, DM, ws + WS_W_QKV, DM, T / 256, NQKV / 256, F.G, F.bid);
        g8::EpiQkvPlanes E{ws + WS_QKV, RSH3, 1.0f / 64.0f};
        for (int rep = 0; rep < ((MK_DUP & 2) ? 2 : 1); ++rep) g8::gemm_phase(ring, F.tid, DM / 2, DM, DM, S, E);
        SEAM(15);
    }
    if (IN(17)) { RF(); for (int rep = 0; rep < ((MK_DUP & 4) ? 2 : 1); ++rep) attn_phase(F, ws + WS_QKV, KF(A_Q_GAIN), KF(A_K_GAIN), (const int*)karg_ptr(A_POS), (bf16_t*)(ws + WS_OG), (float*)(ws + WS_LSE)); SEAM(17); }
    if (IN(18)) { RF(); merge_phase<MK_F8_WO != 0>(F, (const bf16_t*)(ws + WS_OG), (const float*)(ws + WS_LSE), (bf16_t*)(ws + WS_OB)); SEAM(18); }
    if (IN(19)) { RF();
        constexpr bool F8 = MK_F8_WO != 0; constexpr unsigned LD = F8 ? 1024 : 2048;
        g8::StaticSched S; S.init(ws + WS_OB, LD, ws + WS_W_O, LD, T / 256, DM / 256, F.G, F.bid);
        g8::EpiResidT<F8> E{HB, ws + WS_H8, rowss_acc + 2 * T, F8 ? 1.0f / (64.0f * 16.0f) : 1.0f};
        g8::gemm_phase(ring, F.tid, F8 ? 512 : 1024, LD, LD, S, E); SEAM(19);
    }
    MOE_LAYER(20, 1, rowss_acc + 2 * T, rowss_acc + 3 * T, RSH3, true)
#undef IN
#undef SEAM
}

extern "C" void kernel_launch(void* const* d_in, const int* in_sizes, int n_in, void* d_out, int out_size, void* d_ws, size_t ws_size, hipStream_t stream) {
    static int grid = 0;
    if (grid == 0) {
        if (n_in != 28 || in_sizes[0] != T * DM || out_size != T * DM || ws_size < WS_END) {
            fprintf(stderr, "kernel_launch: unexpected problem (n_in %d, in0 %d, out %d, ws %zu < %zu); nothing launched\n", n_in, n_in > 0 ? in_sizes[0] : -1, out_size, ws_size, (size_t)WS_END); grid = -1; return; }
        int dev = 0, cus = 0, per_cu = 0;
        if (hipGetDevice(&dev) != hipSuccess || hipDeviceGetAttribute(&cus, hipDeviceAttributeMultiprocessorCount, dev) != hipSuccess) { grid = -1; return; }
        if (hipFuncSetAttribute((const void*)mk_fwd, hipFuncAttributeMaxDynamicSharedMemorySize, LDS_BYTES) != hipSuccess) { fprintf(stderr, "kernel_launch: hipFuncSetAttribute failed\n"); grid = -1; return; }
        if (hipOccupancyMaxActiveBlocksPerMultiprocessor(&per_cu, (const void*)mk_fwd, 512, LDS_BYTES) != hipSuccess || per_cu < 1)
            fprintf(stderr, "kernel_launch: note: occupancy query reports %d workgroups per CU\n", per_cu);
        (void)hipGetLastError();
        grid = cus;
    }
    if (grid < 0) return;
    if (hipMemsetAsync((char*)d_ws + WS_CTL, 0, CTL_ZERO_BYTES, stream) != hipSuccess) { fprintf(stderr, "kernel_launch: memset failed\n"); return; }
    Args a{};
    for (int i = 0; i < 28; ++i) a.in[i] = d_in[i];
    a.out = (float*)d_out; a.ws = (unsigned char*)d_ws;
    if (N_LAUNCHES == 1) {
        a.ph_lo = 0; a.ph_hi = NPH;
        hipLaunchKernelGGL(mk_fwd, dim3(grid), dim3(512), LDS_BYTES, stream, a);
    } else {
        for (int li = 0; li < NPH; ++li) { a.ph_lo = li; a.ph_hi = li + 1; hipLaunchKernelGGL(mk_fwd, dim3(grid), dim3(512), LDS_BYTES, stream, a); }
    }
    const hipError_t le = hipPeekAtLastError();
    if (le != hipSuccess) fprintf(stderr, "kernel_launch: launch failed: %s\n", hipGetErrorName(le));
}
```
